# Optimizing an MI355X kernel written in HIP

```python
import math
import jax, jax.numpy as jnp
from jax import lax
import numpy as np

D_MODEL = 2048
BATCH = 2
SEQ = 16384
DEPTH = 2

GRID_W = 64
CTX_LEN = 256
EPS = 1e-6

ATTN_WIDTH = D_MODEL // 2
ATTN_V_DIM = 128
ATTN_HEADS = ATTN_WIDTH // ATTN_V_DIM
ATTN_QK_DIM = ATTN_V_DIM // 2
ROPE_AXIS_DIM = ATTN_QK_DIM // 2
ROPE_BASE = 10000.0
Q_BLOCK = 128

POOL_WINDOWS = (2, 4, 8, 16)
POOL_WIDTH = D_MODEL // 4
POOL_GROUP = POOL_WIDTH // len(POOL_WINDOWS)

GMLP_WIDTH = D_MODEL // 4
GMLP_GROUPS = 4
GMLP_GROUP = GMLP_WIDTH // GMLP_GROUPS
GMLP_CHUNK = 128

MIX_WIDTH = ATTN_WIDTH + POOL_WIDTH + GMLP_WIDTH
Q_OFF = 0
K_OFF = ATTN_WIDTH
V_OFF = 2 * ATTN_WIDTH
POOL_OFF = 3 * ATTN_WIDTH
GU_OFF = POOL_OFF + POOL_WIDTH
GV_OFF = GU_OFF + GMLP_WIDTH
IN_COLS = GV_OFF + GMLP_WIDTH

N_GROUPS = 4
EXPERTS_PER_GROUP = 8
N_EXPERTS = N_GROUPS * EXPERTS_PER_GROUP
TOP_K = 2
EXPERT_FF = D_MODEL // 4
MOE_BLOCK = 256

kernel_name = "hybrid_diffattn_pool_gmlp_hmoe_dit"


def rms_norm(x, g):
    xf = x.astype(jnp.float32)
    y = xf * lax.rsqrt(jnp.mean(xf * xf, axis=-1, keepdims=True) + EPS)
    return (y * g.astype(jnp.float32)).astype(x.dtype)


def layer_norm(x, g):
    xf = x.astype(jnp.float32)
    mu = jnp.mean(xf, axis=-1, keepdims=True)
    xc = xf - mu
    y = xc * lax.rsqrt(jnp.mean(xc * xc, axis=-1, keepdims=True) + EPS)
    return (y * g.astype(jnp.float32)).astype(x.dtype)


def axial_angles(n):
    rows = n // GRID_W
    row = jnp.repeat(jnp.arange(rows, dtype=jnp.float32), GRID_W)
    col = jnp.tile(jnp.arange(GRID_W, dtype=jnp.float32), rows)
    half = ROPE_AXIS_DIM // 2
    inv = ROPE_BASE ** (-jnp.arange(half, dtype=jnp.float32) / half)
    return row[:, None] * inv[None, :], col[:, None] * inv[None, :]


def rope_2d(x, ang_r, ang_c):
    half = ROPE_AXIS_DIM // 2

    def rot(seg, ang):
        cos = jnp.cos(ang)[None, :, None, None, :]
        sin = jnp.sin(ang)[None, :, None, None, :]
        a, b = seg[..., :half], seg[..., half:]
        return jnp.concatenate([a * cos - b * sin, b * cos + a * sin], axis=-1)

    xf = x.astype(jnp.float32)
    out = jnp.concatenate([rot(xf[..., :ROPE_AXIS_DIM], ang_r),
                           rot(xf[..., ROPE_AXIS_DIM:], ang_c)], axis=-1)
    return out.astype(x.dtype)


def split_qk(z):
    b, n, _ = z.shape
    return z.reshape(b, n, ATTN_HEADS, 2, ATTN_QK_DIM)


def split_v(z):
    b, n, _ = z.shape
    return z.reshape(b, n, ATTN_HEADS, ATTN_V_DIM)


def diff_attend(q, k, v, lam):
    s = jnp.einsum('bqhmd,bkhmd->bhmqk', q * (ATTN_QK_DIM ** -0.5), k).astype(jnp.float32)
    p = jax.nn.softmax(s, axis=-1)
    a = p[:, :, 0] - lam * p[:, :, 1]
    return jnp.einsum('bhqk,bkhe->bqhe', a.astype(v.dtype), v)


def diff_head_out(o, subln_g, lam_init):
    b, n = o.shape[:2]
    return (rms_norm(o, subln_g) * (1.0 - lam_init)).reshape(b, n, ATTN_WIDTH)


def multiscale_pool(p, pool_w, pool_scale):
    b, n, _ = p.shape
    pf = p.astype(jnp.float32)
    cs = jnp.concatenate([jnp.zeros((b, 1, POOL_WIDTH), jnp.float32),
                          jnp.cumsum(pf, axis=1)], axis=1)
    t = jnp.arange(n)
    outs = []
    for gi, win in enumerate(POOL_WINDOWS):
        lo = jnp.clip(t - win // 2, 0, n - 1)
        hi = jnp.clip(t + (win - 1 - win // 2), 0, n - 1)
        sl = slice(gi * POOL_GROUP, (gi + 1) * POOL_GROUP)
        csg = cs[:, :, sl]
        tot = jnp.take(csg, hi + 1, axis=1) - jnp.take(csg, lo, axis=1)
        cnt = (hi - lo + 1).astype(jnp.float32)[None, :, None]
        outs.append(tot / cnt - pf[:, :, sl])
    d = jnp.stack(outs, axis=2).astype(p.dtype)
    y = jnp.einsum('bngc,gcd->bngd', d, pool_w).reshape(b, n, POOL_WIDTH)
    return y * pool_scale


def chunk_gmlp(u, v, norm_g, ws, bs):
    b, n, _ = u.shape
    u = jax.nn.gelu(u)
    v = layer_norm(jax.nn.gelu(v), norm_g)
    vc = v.reshape(b, n // GMLP_CHUNK, GMLP_CHUNK, GMLP_GROUPS, GMLP_GROUP)
    sv = jnp.einsum('gij,bnjgc->bnigc', ws, vc) + bs.T[None, None, :, :, None]
    return u * sv.reshape(b, n, GMLP_WIDTH)


def local_mixers(proj, pool_w, pool_scale, gmlp_norm_g, gmlp_ws, gmlp_bs):
    y_pool = multiscale_pool(proj[..., POOL_OFF:GU_OFF], pool_w, pool_scale)
    y_gmlp = chunk_gmlp(proj[..., GU_OFF:GV_OFF], proj[..., GV_OFF:IN_COLS],
                        gmlp_norm_g, gmlp_ws, gmlp_bs)
    return y_pool, y_gmlp


def hier_moe(h, rg_w, rg_b, re_w, re_b, w_gate, w_up, w_down):
    T, d = h.shape
    gl = (h @ rg_w).astype(jnp.float32) + rg_b.astype(jnp.float32)
    pg = jax.nn.softmax(gl, axis=-1)
    g_val, g_idx = lax.top_k(pg, 1)
    el = ((h @ re_w).astype(jnp.float32) + re_b.astype(jnp.float32)).reshape(
        T, N_GROUPS, EXPERTS_PER_GROUP)
    el = jnp.take_along_axis(el, g_idx[:, :, None], axis=1)[:, 0]
    pe = jax.nn.softmax(el, axis=-1)
    e_val, e_idx = lax.top_k(pe, TOP_K)
    wts = g_val * e_val / jnp.sum(e_val, axis=-1, keepdims=True)
    eid = g_idx * EXPERTS_PER_GROUP + e_idx

    n_assign = T * TOP_K
    flat_e = eid.reshape(-1).astype(jnp.int32)
    flat_w = wts.reshape(-1)
    flat_t = jnp.repeat(jnp.arange(T, dtype=jnp.int32), TOP_K)
    order = jnp.argsort(flat_e)
    se, sw, st = flat_e[order], flat_w[order], flat_t[order]
    counts = jnp.bincount(flat_e, length=N_EXPERTS)
    start = jnp.cumsum(counts) - counts
    padded = (counts + MOE_BLOCK - 1) // MOE_BLOCK * MOE_BLOCK
    pend = jnp.cumsum(padded)
    pstart = pend - padded
    dest = pstart[se] + jnp.arange(n_assign, dtype=jnp.int32) - start[se]
    n_slots = -(-(n_assign + N_EXPERTS * (MOE_BLOCK - 1)) // MOE_BLOCK) * MOE_BLOCK
    n_blk = n_slots // MOE_BLOCK
    buf_t = jnp.full((n_slots,), T, jnp.int32).at[dest].set(st)
    buf_w = jnp.zeros((n_slots,), jnp.float32).at[dest].set(sw)
    blk_e = jnp.minimum(jnp.searchsorted(pend, jnp.arange(n_blk) * MOE_BLOCK, side='right'),
                        N_EXPERTS - 1)
    h_pad = jnp.concatenate([h, jnp.zeros((1, d), h.dtype)], axis=0)

    def run_block(args):
        tok, w, e = args
        xb = h_pad[tok]
        y = (jax.nn.silu(xb @ w_gate[e]) * (xb @ w_up[e])) @ w_down[e]
        return y * w[:, None].astype(y.dtype)

    yb = lax.map(run_block, (buf_t.reshape(n_blk, MOE_BLOCK),
                             buf_w.reshape(n_blk, MOE_BLOCK), blk_e))
    out = jax.ops.segment_sum(yb.reshape(n_slots, d), buf_t, num_segments=T + 1)
    return out[:T]


def trunk_layer(l, last, x, xc, c, c_ctx, ang_r, ang_c, ada_w, ada_b, norm1_g, norm2_g,
                w_in, q_norm_g, k_norm_g, lam_q1, lam_k1, lam_q2, lam_k2, subln_g,
                pool_w, pool_scale, gmlp_norm_g, gmlp_ws, gmlp_bs, w_out,
                router_g_w, router_g_b, router_e_w, router_e_b, w_gate, w_up, w_down):
    b, n, d = x.shape
    m = (jax.nn.silu(c) @ ada_w + ada_b)[:, None, :]
    sh1, sc1, g1, sh2, sc2, g2 = jnp.split(m, 6, axis=-1)
    n_cmod = 2 if last else 6
    mc = jax.nn.silu(c_ctx) @ ada_w[:, :n_cmod * d] + ada_b[:n_cmod * d]
    cmods = jnp.split(mc, n_cmod, axis=-1)
    csh1, csc1 = cmods[0], cmods[1]

    lam_init = 0.8 - 0.6 * math.exp(-0.3 * l)
    lam = (jnp.exp(jnp.sum(lam_q1.astype(jnp.float32) * lam_k1.astype(jnp.float32)))
           - jnp.exp(jnp.sum(lam_q2.astype(jnp.float32) * lam_k2.astype(jnp.float32)))
           + lam_init)

    h = rms_norm(x, norm1_g) * (1 + sc1) + sh1
    hc = rms_norm(xc, norm1_g) * (1 + csc1) + csh1
    proj = h @ w_in
    if last:
        kv_c = hc @ w_in[:, K_OFF:POOL_OFF]
        kc_raw, vc_raw = kv_c[..., :ATTN_WIDTH], kv_c[..., ATTN_WIDTH:]
    else:
        proj_c = hc @ w_in
        kc_raw, vc_raw = proj_c[..., K_OFF:V_OFF], proj_c[..., V_OFF:POOL_OFF]
    kc = rms_norm(split_qk(kc_raw), k_norm_g)
    vc = split_v(vc_raw)

    q = rope_2d(rms_norm(split_qk(proj[..., Q_OFF:K_OFF]), q_norm_g), ang_r, ang_c)
    k = rope_2d(rms_norm(split_qk(proj[..., K_OFF:V_OFF]), k_norm_g), ang_r, ang_c)
    v = split_v(proj[..., V_OFF:POOL_OFF])
    k_all = jnp.concatenate([kc, k], axis=1)
    v_all = jnp.concatenate([vc, v], axis=1)
    nb = n // Q_BLOCK
    q_blocks = jnp.moveaxis(q.reshape(b, nb, Q_BLOCK, ATTN_HEADS, 2, ATTN_QK_DIM), 1, 0)
    o = lax.map(lambda qb: diff_attend(qb, k_all, v_all, lam), q_blocks)
    o = jnp.moveaxis(o, 0, 1).reshape(b, n, ATTN_HEADS, ATTN_V_DIM)
    y_attn = diff_head_out(o, subln_g, lam_init)
    y_pool, y_gmlp = local_mixers(proj, pool_w, pool_scale, gmlp_norm_g, gmlp_ws, gmlp_bs)
    x = x + g1 * (jnp.concatenate([y_attn, y_pool, y_gmlp], axis=-1) @ w_out)

    if not last:
        cg1, csh2, csc2, cg2 = cmods[2], cmods[3], cmods[4], cmods[5]
        qc = rms_norm(split_qk(proj_c[..., Q_OFF:K_OFF]), q_norm_g)
        yc_attn = diff_head_out(diff_attend(qc, kc, vc, lam), subln_g, lam_init)
        yc_pool, yc_gmlp = local_mixers(proj_c, pool_w, pool_scale, gmlp_norm_g, gmlp_ws, gmlp_bs)
        xc = xc + cg1 * (jnp.concatenate([yc_attn, yc_pool, yc_gmlp], axis=-1) @ w_out)

    h2 = rms_norm(x, norm2_g) * (1 + sc2) + sh2
    tokens = h2.reshape(b * n, d)
    if not last:
        hc2 = rms_norm(xc, norm2_g) * (1 + csc2) + csh2
        tokens = jnp.concatenate([tokens, hc2.reshape(-1, d)], axis=0)
    f = hier_moe(tokens, router_g_w, router_g_b, router_e_w, router_e_b, w_gate, w_up, w_down)
    x = x + g2 * f[:b * n].reshape(b, n, d)
    if not last:
        xc = xc + cg2 * f[b * n:].reshape(xc.shape)
    return x, xc


def setup_inputs(seed: int = 0) -> dict:
    key = jax.random.key(seed)
    ks = iter(jax.random.split(key, 40))
    L, D = DEPTH, D_MODEL

    def nrm(shape, scale):
        return jax.random.normal(next(ks), shape, jnp.float32) * scale

    def gain(shape):
        return 1.0 + nrm(shape, 0.1)

    return {
        "x": nrm((BATCH, SEQ, D), 1.0),
        "c": nrm((BATCH, D), 1.0),
        "ctx": nrm((BATCH, CTX_LEN, D), 1.0),
        "c_ctx": nrm((D,), 1.0),
        "ada_w": nrm((L, D, 6 * D), 0.5 * D ** -0.5),
        "ada_b": nrm((L, 6 * D), 0.02),
        "norm1_g": gain((L, D)),
        "norm2_g": gain((L, D)),
        "w_in": nrm((L, D, IN_COLS), D ** -0.5),
        "q_norm_g": gain((L, ATTN_QK_DIM)),
        "k_norm_g": gain((L, ATTN_QK_DIM)),
        "lam_q1": nrm((L, ATTN_QK_DIM), 0.1),
        "lam_k1": nrm((L, ATTN_QK_DIM), 0.1),
        "lam_q2": nrm((L, ATTN_QK_DIM), 0.1),
        "lam_k2": nrm((L, ATTN_QK_DIM), 0.1),
        "subln_g": gain((L, ATTN_V_DIM)),
        "pool_w": nrm((L, len(POOL_WINDOWS), POOL_GROUP, POOL_GROUP), POOL_GROUP ** -0.5),
        "pool_scale": gain((L, POOL_WIDTH)),
        "gmlp_norm_g": gain((L, GMLP_WIDTH)),
        "gmlp_ws": nrm((L, GMLP_GROUPS, GMLP_CHUNK, GMLP_CHUNK), GMLP_CHUNK ** -0.5),
        "gmlp_bs": gain((L, GMLP_GROUPS, GMLP_CHUNK)),
        "w_out": nrm((L, MIX_WIDTH, D), MIX_WIDTH ** -0.5),
        "router_g_w": nrm((L, D, N_GROUPS), D ** -0.5),
        "router_g_b": nrm((L, N_GROUPS), 0.01),
        "router_e_w": nrm((L, D, N_EXPERTS), D ** -0.5),
        "router_e_b": nrm((L, N_EXPERTS), 0.01),
        "w_gate": nrm((L, N_EXPERTS, D, EXPERT_FF), D ** -0.5),
        "w_up": nrm((L, N_EXPERTS, D, EXPERT_FF), D ** -0.5),
        "w_down": nrm((L, N_EXPERTS, EXPERT_FF, D), EXPERT_FF ** -0.5),
    }


def reference(x, c, ctx, c_ctx, ada_w, ada_b, norm1_g, norm2_g, w_in, q_norm_g, k_norm_g,
              lam_q1, lam_k1, lam_q2, lam_k2, subln_g, pool_w, pool_scale, gmlp_norm_g,
              gmlp_ws, gmlp_bs, w_out, router_g_w, router_g_b, router_e_w, router_e_b,
              w_gate, w_up, w_down):
    ang_r, ang_c = axial_angles(x.shape[1])
    xc = ctx
    for l in range(DEPTH):
        x, xc = trunk_layer(
            l, l == DEPTH - 1, x, xc, c, c_ctx, ang_r, ang_c,
            ada_w[l], ada_b[l], norm1_g[l], norm2_g[l], w_in[l], q_norm_g[l], k_norm_g[l],
            lam_q1[l], lam_k1[l], lam_q2[l], lam_k2[l], subln_g[l], pool_w[l], pool_scale[l],
            gmlp_norm_g[l], gmlp_ws[l], gmlp_bs[l], w_out[l], router_g_w[l], router_g_b[l],
            router_e_w[l], router_e_b[l], w_gate[l], w_up[l], w_down[l])
    return x
```

```cpp
#include <hip/hip_runtime.h>
#include <cstdio>
#include <cstdint>

#ifndef MK_MULTI
#define MK_MULTI 0
#endif

constexpr int D = 2048, NB = 2, SEQ = 16384, CTX = 256, DEPTH = 2;
constexpr int SEQV = SEQ + CTX;
constexpr int TV = NB * SEQV;
constexpr int INC = 4608;
constexpr int NH = 8;
constexpr int Q_OFF = 0, K_OFF = 1024, V_OFF = 2048, POOL_OFF = 3072, GU_OFF = 3584, GV_OFF = 4096;
constexpr int NEXP = 32, FF = 512;
constexpr int NSLOT_MAX = 74752;
constexpr int NBLK_MAX = NSLOT_MAX / 256;
constexpr float EPS = 1e-6f;
constexpr float QSCALE = 0.125f * 1.4426950408889634f;

typedef unsigned short bf16_t;
typedef short bf16x8 __attribute__((ext_vector_type(8)));
typedef short s16x4 __attribute__((ext_vector_type(4)));
typedef float f32x2 __attribute__((ext_vector_type(2)));
typedef float f32x4 __attribute__((ext_vector_type(4)));
typedef float f32x16 __attribute__((ext_vector_type(16)));
typedef unsigned u32x2 __attribute__((ext_vector_type(2)));
typedef unsigned u32x4 __attribute__((ext_vector_type(4)));
typedef __bf16 bfv2 __attribute__((ext_vector_type(2)));
#define LAS __attribute__((address_space(3)))
#define DI __device__ __forceinline__
#define GAS __attribute__((address_space(1)))

DI unsigned pk2(float a, float b) { f32x2 v = {a, b}; bfv2 r = __builtin_convertvector(v, bfv2); return __builtin_bit_cast(unsigned, r); }
DI float bflo(unsigned w) { return __uint_as_float(w << 16); }
DI float bfhi(unsigned w) { return __uint_as_float(w & 0xffff0000u); }
DI float bf1(bf16_t h) { return __uint_as_float(((unsigned)h) << 16); }
DI int lane_id() { return (int)__builtin_amdgcn_mbcnt_hi(~0u, __builtin_amdgcn_mbcnt_lo(~0u, 0u)); }
DI int opaque_tid(int wv) { int w = wv, l = lane_id(); asm volatile("" : "+s"(w), "+v"(l)); return (w << 6) | l; }
DI float wave_sum(float v) {
#pragma unroll
    for (int o = 32; o >= 1; o >>= 1) v += __shfl_xor(v, o);
    return v;
}
DI float gelu_tanh(float x) {
    const float u = x * (-2.3022081981f - 0.10294323958f * x * x);
    return x * __builtin_amdgcn_rcpf(1.0f + __builtin_amdgcn_exp2f(u));
}
DI float silu_f(float x) { return x * __builtin_amdgcn_rcpf(1.0f + __expf(-x)); }

constexpr size_t al256(size_t x) { return (x + 255) / 256 * 256; }
constexpr size_t WS_CTL   = 0;
constexpr size_t CTL_BYTES = 65536;
constexpr size_t CW_CNT   = 16384;
constexpr size_t WS_MOD   = WS_CTL + CTL_BYTES;
constexpr size_t WS_LAM   = WS_MOD + al256((size_t)2 * 3 * 6 * D * 4);
constexpr size_t WS_ROPE  = WS_LAM + 256;
constexpr size_t WS_WSB   = WS_ROPE + 2 * 256 * 16 * 4;
constexpr size_t WS_PWT   = WS_WSB + (size_t)2 * 4 * 128 * 128 * 2;
constexpr size_t WS_RWT   = WS_PWT + (size_t)2 * 4 * 128 * 128 * 2;
constexpr size_t WS_WIN   = WS_RWT + (size_t)2 * 256 * D * 2;
constexpr size_t WS_WOUT  = WS_WIN + (size_t)2 * INC * D;
constexpr size_t WS_GU    = WS_WOUT + (size_t)2 * D * D * 2;
constexpr size_t WS_WD    = WS_GU + (size_t)2 * NEXP * 1024 * D;
constexpr size_t WS_ACT   = WS_WD + (size_t)2 * NEXP * D * FF;
constexpr size_t WS_PROJ  = WS_ACT + (size_t)TV * D * 2;
constexpr size_t PROJ_BYTES = (size_t)TV * INC * 2;
static_assert((size_t)NSLOT_MAX * D * 2 <= PROJ_BYTES, "YBUF must fit in PROJ");
constexpr size_t WS_OPART = WS_PROJ + al256(PROJ_BYTES);
constexpr size_t OPART_BYTES = (size_t)160 << 20;
constexpr size_t OFF_LOGITS = 0, OFF_HID = al256((size_t)TV * 64 * 4);
constexpr size_t OFF_ACT8 = OFF_HID + al256((size_t)NSLOT_MAX * FF * 2);
static_assert(OFF_ACT8 + (size_t)TV * D <= OPART_BYTES, "HID + ACT8 must fit in OPART");
constexpr size_t WS_XB    = WS_OPART + al256(OPART_BYTES);
constexpr size_t WS_ASGE  = WS_XB + (size_t)TV * D * 2;
constexpr size_t WS_ASGP  = WS_ASGE + al256((size_t)TV * 2 * 4);
constexpr size_t WS_ASGW  = WS_ASGP + al256((size_t)TV * 2 * 4);
constexpr size_t WS_SLOT  = WS_ASGW + al256((size_t)TV * 2 * 4);
constexpr size_t WS_BUFT  = WS_SLOT + al256((size_t)TV * 2 * 4);
constexpr size_t WS_BUFW  = WS_BUFT + al256((size_t)NSLOT_MAX * 4);
constexpr size_t WS_BLKE  = WS_BUFW + al256((size_t)NSLOT_MAX * 4);
constexpr size_t WS_KIMG  = WS_BLKE + al256((size_t)(NBLK_MAX + 4) * 4);
constexpr int NTILE = SEQV / 64;
constexpr size_t WS_VIMG  = WS_KIMG + (size_t)NB * 16 * NTILE * 4096;
constexpr size_t WS_Q8    = WS_VIMG + (size_t)NB * 8 * NTILE * 8192;
constexpr size_t WS_PARK  = WS_Q8 + (size_t)TV * 1024;
constexpr size_t WS_END   = WS_PARK + (size_t)512 * 512 * 128;

constexpr int LDS_BYTES = 147456;
constexpr int MISC_OFF = LDS_BYTES - 64;

#define XB_TMO      128
#define XB_XCNT(j)  (256  + 64 * (j))
#define XB_XSUB(j)  (1280 + 64 * (j))
#define XB_XGEN(j)  (2304 + 64 * (j))
#define XB_TOP      3328
#define XB_TOPGEN   3392
#define XCD_BAR_WORDS 3456
#define XB_SPIN_CAP (1u << 21)

__device__ __forceinline__ unsigned xb_ld(unsigned* p)              { return __hip_atomic_load(p, __ATOMIC_RELAXED, __HIP_MEMORY_SCOPE_AGENT); }
__device__ __forceinline__ unsigned xb_add(unsigned* p, unsigned v) { return __hip_atomic_fetch_add(p, v, __ATOMIC_RELAXED, __HIP_MEMORY_SCOPE_AGENT); }
__device__ __forceinline__ unsigned xb_xcc_id() { return (unsigned)__builtin_amdgcn_s_getreg((3 << 11) | 20) & 0xFu; }
#define XB_SPIN(cond, bar) do { unsigned _sp = 0; while (cond) { __builtin_amdgcn_s_sleep(1); \
    if ((++_sp & 255u) == 0u) { if (xb_ld(&(bar)[XB_TMO])) break; if (_sp > XB_SPIN_CAP) { atomicAdd(&(bar)[XB_TMO], 1u); break; } } } } while (0)

struct XcdBarrier {
    unsigned* bar; unsigned x; int wv;
    volatile LAS unsigned* st;
};

__device__ __forceinline__ XcdBarrier xcd_barrier_post(unsigned* bar, volatile LAS unsigned* st, int wv) {
    XcdBarrier b; b.bar = bar; b.x = xb_xcc_id(); b.st = st; b.wv = wv;
    if (wv == 0 && lane_id() == 0) (void)xb_add(&bar[XB_XCNT(b.x)], 1u);
    return b;
}
__device__ __forceinline__ void xcd_barrier_complete(unsigned* bar, unsigned x, unsigned& nloc, unsigned& nx) {
    const unsigned G = gridDim.x * gridDim.y * gridDim.z;
    unsigned sum, cnt, mine, sp = 0u;
    for (;;) {
        sum = 0u; cnt = 0u; mine = 0u;
#pragma unroll
        for (unsigned j = 0; j < 16; ++j) { const unsigned c = xb_ld(&bar[XB_XCNT(j)]); sum += c; cnt += (c > 0u) ? 1u : 0u; mine = (j == x) ? c : mine; }
        if (sum == G) break;
        __builtin_amdgcn_s_sleep(1);
        if ((++sp & 255u) == 0u) { if (xb_ld(&bar[XB_TMO])) break; if (sp > XB_SPIN_CAP) { atomicAdd(&bar[XB_TMO], 1u); break; } }
    }
    nloc = mine > 0u ? mine : 1u; nx = cnt > 0u ? cnt : 1u;
}

__device__ __forceinline__ void xcd_barrier(const XcdBarrier& b) {
    asm volatile("s_waitcnt vmcnt(0)" ::: "memory");
    __syncthreads();
    if (b.wv == 0 && lane_id() == 0) {
        unsigned* bar = b.bar;
        __builtin_amdgcn_s_waitcnt(0);
        unsigned nloc = b.st[0], nx = b.st[1];
        if (nloc == 0u) { xcd_barrier_complete(bar, b.x, nloc, nx); b.st[0] = nloc; b.st[1] = nx; }
        const unsigned old = xb_add(&bar[XB_XSUB(b.x)], 1u);
        const unsigned gen = old / nloc;
        if (old + 1u == (gen + 1u) * nloc) {
            __builtin_amdgcn_fence(__ATOMIC_RELEASE, "agent");
            asm volatile("s_waitcnt vmcnt(0)" ::: "memory");
            const unsigned og = xb_add(&bar[XB_TOP], 1u);
            const unsigned tg = og / nx;
            if (og + 1u == (tg + 1u) * nx) xb_add(&bar[XB_TOPGEN], 1u);
            else XB_SPIN(xb_ld(&bar[XB_TOPGEN]) == tg, bar);
            __builtin_amdgcn_fence(__ATOMIC_ACQUIRE, "agent");
            xb_add(&bar[XB_XGEN(b.x)], 1u);
            asm volatile("s_waitcnt vmcnt(0)" ::: "memory");
        } else {
            XB_SPIN(xb_ld(&bar[XB_XGEN(b.x)]) == gen, bar);
            __builtin_amdgcn_fence(__ATOMIC_ACQUIRE, "agent");
            asm volatile("s_waitcnt vmcnt(0)" ::: "memory");
        }
    }
    __syncthreads();
}

namespace pg8 {
constexpr int BM = 256, BK = 64, HALF = 128, HTB = HALF * BK * 2  , STAGE_BYTES = 8 * HTB, NXCD = 8, WGM = 8;

__host__ __device__ __forceinline__ int lds_byte(int r, int c) { const int st = (r >> 4) * 2 + (c >> 5), rr = r & 15, cc = c & 31, ob = rr * 64 + cc * 2; return st * 1024 + (ob ^ (((ob >> 9) & 1) << 5)); }
__host__ __device__ __forceinline__ void stage_rc(int b, int& R, int& C) { const int st = b / 1024, sb = b % 1024, swz = sb ^ (((sb >> 9) & 1) << 5); R = (st >> 1) * 16 + swz / 64; C = (st & 1) * 32 + (swz % 64) / 2; }
__host__ __device__ __forceinline__ int perm32(int rho) { const int n = rho >> 4, i = rho & 15; return 8 * (i >> 2) + 4 * n + (i & 3); }

struct Unit { int pm, pn; };
struct Gemm { const bf16_t* A; const bf16_t* Bt; int K; const int* gath; };

struct StaticOrder {
    int nM, nN, nwg, G, c, skipctx;
    __device__ void init(int nM_, int nN_, int G_, int c_, int skipctx_) { nM = nM_; nN = nN_; nwg = nM * nN; G = G_; c = c_; skipctx = skipctx_; }
    __device__ bool next(int i, Unit& u) const {
        const long L = (long)i * G + c; if (L >= nwg) return false;
        int wgid = (int)L; { const int q = nwg / NXCD, r = nwg % NXCD, xcd = wgid % NXCD, off = wgid / NXCD; wgid = (xcd < r ? xcd * (q + 1) : r * (q + 1) + (xcd - r) * q) + off; }
        const int nig = WGM * nN, gid = wgid / nig, fm = gid * WGM, gsz = (nM - fm) < WGM ? (nM - fm) : WGM;
        int pm = fm + ((wgid % nig) % gsz); u.pn = (wgid % nig) / gsz;
        if (skipctx) pm = pm + 1 + (pm >= 64);
        u.pm = pm; return true;
    }
};
struct MoeOrder {
    const int* blk_e; int n_units, G, c, NT;
    __device__ bool next(int i, Unit& u) const {
        const long L = (long)i * G + c; if (L >= n_units) return false;
        const int blk = (int)L / NT, j = (int)L % NT; u.pm = blk; u.pn = __builtin_amdgcn_readfirstlane(blk_e[blk]) * NT + j; return true;
    }
};

typedef int i32x8 __attribute__((ext_vector_type(8)));
typedef int u32x4_i __attribute__((ext_vector_type(4)));
template <class Epi, class Sched, bool GATHER, bool FP8 = false>
__device__ __forceinline__ void gemm_phase(LAS unsigned char* lds, const Gemm g, const Sched& S, const Epi& E, int wv) {
    const int tid = opaque_tid(wv), wid = __builtin_amdgcn_readfirstlane(tid >> 6), lane = tid & 63, wr = wid >> 2, wc = wid & 3, fr = lane & 15, fq = lane >> 4;
    constexpr int ES = FP8 ? 1 : 2;
    const int K = g.K, KB = K * ES, nt = KB / 128;
    unsigned voffB[2][2]; unsigned vA[2][2], vAn[2][2];
    const size_t kstep = (size_t)(BK * 2);
    const size_t hstep = (size_t)HALF * KB;
    const size_t tstep = 2 * hstep;
#pragma unroll
    for (int i = 0; i < 2; ++i) { int R, C; stage_rc(tid * 16 + i * 8192, R, C);
#pragma unroll
        for (int h = 0; h < 2; ++h) { const int Rb = Epi::PERM == 2 ? 64 * (R >> 5) + 16 * ((R & 15) >> 2) + 8 * h + 4 * ((R >> 4) & 1) + (R & 3)
                                                     : HALF * h + (Epi::PERM == 1 ? ((R & ~31) + perm32(R & 31)) : R);
            voffB[h][i] = (unsigned)(Rb * KB + C * 2); }
        vA[0][i] = (unsigned)(R * KB + C * 2); vA[1][i] = vA[0][i] + (unsigned)hstep; vAn[0][i] = vA[0][i]; vAn[1][i] = vA[1][i]; }
    const unsigned ldsw = (unsigned)wid * 1024u, lds32 = (unsigned)(size_t)lds;
    const int aoff = lds_byte(wr * 64 + fr, fq * 8); int boff = lds_byte(wc * 32 + fr, fq * 8) + 4 * HTB;
    asm volatile("" : "+v"(boff));
#define PG8_SA(b, h) (((b) * 2 + (h)) * HTB)
#define PG8_SB(b, h) ((4 + (b) * 2 + (h)) * HTB)
#define PG8_SBR(b, h) (((b) * 2 + (h)) * HTB)
#define PG8_STAGE(bufoff, gbase, voff) do { _Pragma("unroll") for (int _i = 0; _i < 2; ++_i) \
        asm volatile("s_nop 0\n\tglobal_load_lds_dwordx4 %0, %1" :: "v"((voff)[_i]), "s"((const char*)(gbase)), "{m0}"(lds32 + (unsigned)(bufoff) + ldsw + (unsigned)(_i * 8192)) : "memory"); } while (0)
#define PG8_LD16(off) (*(const LAS u32x4_i*)(lds + (off)))
#define PG8_LDA(dst, b, h) do { _Pragma("unroll") for (int m = 0; m < 4; ++m) { if constexpr (FP8) { const u32x4_i _x = PG8_LD16(PG8_SA(b, h) + aoff + m * 2048), _y = PG8_LD16(PG8_SA(b, h) + aoff + m * 2048 + 1024); \
            dst##8[m] = __builtin_shufflevector(_x, _y, 0, 1, 2, 3, 4, 5, 6, 7); } \
        else { _Pragma("unroll") for (int k = 0; k < 2; ++k) dst[m][k] = *(const LAS bf16x8*)(lds + PG8_SA(b, h) + aoff + m * 2048 + k * 1024); } } } while (0)
#define PG8_LDB(dst, b, h) do { _Pragma("unroll") for (int n = 0; n < 2; ++n) { if constexpr (FP8) { const u32x4_i _x = PG8_LD16(PG8_SBR(b, h) + boff + n * 2048), _y = PG8_LD16(PG8_SBR(b, h) + boff + n * 2048 + 1024); \
            dst##8[n] = __builtin_shufflevector(_x, _y, 0, 1, 2, 3, 4, 5, 6, 7); } \
        else { _Pragma("unroll") for (int k = 0; k < 2; ++k) dst[n][k] = *(const LAS bf16x8*)(lds + PG8_SBR(b, h) + boff + n * 2048 + k * 1024); } } } while (0)
#define PG8_MMA(ai, bj, At, Bt) do { __builtin_amdgcn_s_setprio(1); _Pragma("unroll") for (int m = 0; m < 4; ++m) _Pragma("unroll") for (int n = 0; n < 2; ++n) { \
        if constexpr (FP8) asm volatile("v_mfma_f32_16x16x128_f8f6f4 %0, %1, %2, %0" : "+v"(acc[ai][bj][m][n]) : "v"(Bt##8[n]), "v"(At##8[m])); \
        else { _Pragma("unroll") for (int k = 0; k < 2; ++k) acc[ai][bj][m][n] = __builtin_amdgcn_mfma_f32_16x16x32_bf16(Bt[n][k], At[m][k], acc[ai][bj][m][n], 0, 0, 0); } } \
        __builtin_amdgcn_s_setprio(0); } while (0)
#define PG8_WAIT_V(n) asm volatile("s_waitcnt vmcnt(" #n ")" ::: "memory")
#define PG8_WAIT_L(n) asm volatile("s_waitcnt lgkmcnt(" #n ")" ::: "memory")
#define PG8_BAR __builtin_amdgcn_s_barrier()
#define PG8_SCHED __builtin_amdgcn_sched_barrier(0)
#define PG8_GATH(dst, pm_) do { _Pragma("unroll") for (int _i = 0; _i < 2; ++_i) { int _R, _C; stage_rc(opaque_tid(wv) * 16 + _i * 8192, _R, _C); \
        _Pragma("unroll") for (int _h = 0; _h < 2; ++_h) { int _t = g.gath[(pm_) * BM + _h * HALF + _R]; _t = _t < 0 ? 0 : _t; dst[_h][_i] = (unsigned)(_t * KB + _C * 2); } } } while (0)
    Unit cur, nxt; int ui = 0;
    if (!S.next(0, cur)) return;
    f32x4 acc[2][2][4][2];
#pragma unroll
    for (int a = 0; a < 2; ++a)
#pragma unroll
        for (int b = 0; b < 2; ++b)
#pragma unroll
            for (int m = 0; m < 4; ++m)
#pragma unroll
                for (int n = 0; n < 2; ++n) acc[a][b][m][n] = (f32x4){0.f, 0.f, 0.f, 0.f};
    bf16x8 At[4][2], B0[2][2], B1[2][2]; i32x8 At8[4], B08[2], B18[2];
    const char* cA = GATHER ? (const char*)g.A : (const char*)g.A + (size_t)cur.pm * tstep; const char* cB = (const char*)g.Bt + (size_t)cur.pn * tstep;
    if (GATHER) { PG8_GATH(vA, cur.pm); }
    PG8_STAGE(PG8_SB(0, 0), cB, voffB[0]); PG8_STAGE(PG8_SA(0, 0), cA, vA[0]); PG8_STAGE(PG8_SB(0, 1), cB, voffB[1]); PG8_STAGE(PG8_SA(0, 1), cA, vA[1]);
    if (wr == 1) PG8_BAR;
    PG8_WAIT_V(4); PG8_BAR;
    PG8_STAGE(PG8_SB(1, 0), cB + kstep, voffB[0]); PG8_STAGE(PG8_SA(1, 0), cA + kstep, vA[0]); PG8_STAGE(PG8_SB(1, 1), cB + kstep, voffB[1]);
    PG8_WAIT_V(6); PG8_BAR;
    for (;;) {
        const bool has_next = S.next(ui + 1, nxt);
        const char* nA = GATHER ? cA : (has_next ? (const char*)g.A + (size_t)nxt.pm * tstep : cA); const char* nB = has_next ? (const char*)g.Bt + (size_t)nxt.pn * tstep : cB;
        if (GATHER) { if (has_next) { PG8_GATH(vAn, nxt.pm); } else {
#pragma unroll
            for (int h = 0; h < 2; ++h)
#pragma unroll
                for (int i = 0; i < 2; ++i) vAn[h][i] = vA[h][i]; } }
        for (int t = 0; t < nt; t += 2) {
            const bool last = (t == nt - 2);
            const char* a1 = cA + (size_t)(t + 1) * kstep;
            const char* a2 = last ? nA : cA + (size_t)(t + 2) * kstep; const char* b2 = last ? nB : cB + (size_t)(t + 2) * kstep;
            const char* a3 = a2 + kstep; const char* b3 = b2 + kstep;
            unsigned w0[2], w1[2];
#pragma unroll
            for (int i = 0; i < 2; ++i) { w0[i] = (GATHER && last) ? vAn[0][i] : vA[0][i]; w1[i] = (GATHER && last) ? vAn[1][i] : vA[1][i]; }
            PG8_LDB(B0, 0, 0); PG8_SCHED; PG8_LDA(At, 0, 0); PG8_STAGE(PG8_SA(1, 1), a1, vA[1]);
            PG8_WAIT_L(8); PG8_BAR; PG8_WAIT_L(0); PG8_MMA(0, 0, At, B0); PG8_BAR; PG8_SCHED;
            PG8_LDB(B1, 0, 1); PG8_STAGE(PG8_SB(0, 0), b2, voffB[0]);
            PG8_BAR; PG8_WAIT_L(0); PG8_MMA(0, 1, At, B1); PG8_BAR;
            PG8_LDA(At, 0, 1); PG8_STAGE(PG8_SA(0, 0), a2, w0);
            PG8_BAR; PG8_WAIT_L(0); PG8_MMA(1, 0, At, B0); PG8_BAR; PG8_SCHED;
            PG8_STAGE(PG8_SB(0, 1), b2, voffB[1]);
            PG8_WAIT_V(6); PG8_BAR; PG8_MMA(1, 1, At, B1); PG8_BAR;
            PG8_LDB(B0, 1, 0); PG8_SCHED; PG8_LDA(At, 1, 0); PG8_STAGE(PG8_SA(0, 1), a2, w1);
            PG8_WAIT_L(8); PG8_BAR; PG8_WAIT_L(0); PG8_MMA(0, 0, At, B0); PG8_BAR; PG8_SCHED;
            PG8_LDB(B1, 1, 1); PG8_STAGE(PG8_SB(1, 0), b3, voffB[0]);
            PG8_BAR; PG8_WAIT_L(0); PG8_MMA(0, 1, At, B1); PG8_BAR;
            PG8_LDA(At, 1, 1); PG8_STAGE(PG8_SA(1, 0), a3, w0);
            PG8_BAR; PG8_WAIT_L(0); PG8_MMA(1, 0, At, B0); PG8_BAR; PG8_SCHED;
            PG8_STAGE(PG8_SB(1, 1), b3, voffB[1]);
            PG8_WAIT_V(6); PG8_BAR; PG8_MMA(1, 1, At, B1); PG8_BAR;
        }
        if constexpr (FP8) asm volatile("s_nop 15\n\ts_nop 15\n\ts_nop 7" ::: "memory");
        E(acc, cur, wr, wc, fr, fq);
        if (!has_next) break;
#pragma unroll
        for (int a = 0; a < 2; ++a)
#pragma unroll
            for (int b = 0; b < 2; ++b)
#pragma unroll
                for (int m = 0; m < 4; ++m)
#pragma unroll
                    for (int n = 0; n < 2; ++n) acc[a][b][m][n] = (f32x4){0.f, 0.f, 0.f, 0.f};
        cur = nxt; cA = nA; cB = nB; ++ui;
#pragma unroll
        for (int h = 0; h < 2; ++h)
#pragma unroll
            for (int i = 0; i < 2; ++i) vA[h][i] = vAn[h][i];
    }
    PG8_WAIT_V(0);
    if (wr == 0) PG8_BAR;
    PG8_BAR;
#undef PG8_SA
#undef PG8_SB
#undef PG8_SBR
#undef PG8_STAGE
#undef PG8_LDA
#undef PG8_LD16
#undef PG8_LDB
#undef PG8_MMA
#undef PG8_WAIT_V
#undef PG8_WAIT_L
#undef PG8_BAR
#undef PG8_SCHED
#undef PG8_GATH
}

struct EpiProj {
    static constexpr int PERM = 2;
    unsigned char* P8; bf16_t* P16; float sc;
    __device__ __forceinline__ void operator()(const f32x4 (&acc)[2][2][4][2], const Unit& u, int wr, int wc, int fr, int fq) const {
        const int row0 = u.pm * BM + wr * 64 + fr;
        if (u.pn < 12) {
            const int col0 = u.pn * BM + wc * 64 + 16 * fq;
#pragma unroll
            for (int ai = 0; ai < 2; ++ai)
#pragma unroll
                for (int m = 0; m < 4; ++m) { unsigned char* rowp = P8 + (size_t)(row0 + ai * HALF + m * 16) * 3072 + col0; int w[4];
#pragma unroll
                    for (int bj = 0; bj < 2; ++bj)
#pragma unroll
                        for (int n = 0; n < 2; ++n) { const f32x4 v = acc[ai][bj][m][n] * sc;
                            int x = __builtin_amdgcn_cvt_pk_fp8_f32(v[0], v[1], 0, false); x = __builtin_amdgcn_cvt_pk_fp8_f32(v[2], v[3], x, true); w[bj * 2 + n] = x; }
                    u32x4 o; o.x = (unsigned)w[0]; o.y = (unsigned)w[1]; o.z = (unsigned)w[2]; o.w = (unsigned)w[3]; *(u32x4*)rowp = o; }
        } else {
            const int col0 = (u.pn - 12) * BM + wc * 64 + 16 * fq;
#pragma unroll
            for (int ai = 0; ai < 2; ++ai)
#pragma unroll
                for (int m = 0; m < 4; ++m) { bf16_t* rowp = P16 + (size_t)(row0 + ai * HALF + m * 16) * 1536 + col0;
#pragma unroll
                    for (int bj = 0; bj < 2; ++bj) { const f32x4 v0 = acc[ai][bj][m][0] * sc, v1 = acc[ai][bj][m][1] * sc;
                        u32x4 w; w.x = pk2(v0[0], v0[1]); w.y = pk2(v0[2], v0[3]); w.z = pk2(v1[0], v1[1]); w.w = pk2(v1[2], v1[3]);
                        *(u32x4*)(rowp + bj * 8) = w; } }
        }
    }
};
struct EpiWout {
    static constexpr int PERM = 1;
    bf16_t* X; const float* mod_l;
    __device__ __forceinline__ void operator()(const f32x4 (&acc)[2][2][4][2], const Unit& u, int wr, int wc, int fr, int fq) const {
        const int b = u.pm >= 65, jt = u.pm - 65 * b; const bool isctx = (jt == 0);
        const float* g1 = mod_l + (size_t)(isctx ? 2 : b) * 6 * D + 2 * D;
        const int row0 = u.pm * BM + wr * 64 + fr, col0 = u.pn * BM + wc * 32 + 8 * fq;
        f32x4 gv[2][2];
#pragma unroll
        for (int bj = 0; bj < 2; ++bj)
#pragma unroll
            for (int n = 0; n < 2; ++n) gv[bj][n] = *(const f32x4*)(g1 + col0 + bj * HALF + n * 4);
#pragma unroll
        for (int ai = 0; ai < 2; ++ai)
#pragma unroll
            for (int m = 0; m < 4; ++m) { bf16_t* rp = X + (size_t)(row0 + ai * HALF + m * 16) * D + col0;
#pragma unroll
                for (int bj = 0; bj < 2; ++bj) { const u32x4 xw = *(const u32x4*)(rp + bj * HALF);
                    const f32x4 x0 = (f32x4){bflo(xw.x), bfhi(xw.x), bflo(xw.y), bfhi(xw.y)} + gv[bj][0] * acc[ai][bj][m][0];
                    const f32x4 x1 = (f32x4){bflo(xw.z), bfhi(xw.z), bflo(xw.w), bfhi(xw.w)} + gv[bj][1] * acc[ai][bj][m][1];
                    u32x4 w; w.x = pk2(x0[0], x0[1]); w.y = pk2(x0[2], x0[3]); w.z = pk2(x1[0], x1[1]); w.w = pk2(x1[2], x1[3]); *(u32x4*)(rp + bj * HALF) = w; } }
    }
};
struct EpiGU {
    static constexpr int PERM = 1;
    unsigned char* H; float sc;
    __device__ __forceinline__ void operator()(const f32x4 (&acc)[2][2][4][2], const Unit& u, int wr, int wc, int fr, int fq) const {
        const int row0 = u.pm * BM + wr * 64 + fr, col0 = (u.pn & 3) * 128 + wc * 32 + 8 * fq;
#pragma unroll
        for (int ai = 0; ai < 2; ++ai)
#pragma unroll
            for (int m = 0; m < 4; ++m) { unsigned char* rowp = H + (size_t)(row0 + ai * HALF + m * 16) * FF + col0;
                float h[8];
#pragma unroll
                for (int n = 0; n < 2; ++n)
#pragma unroll
                    for (int j = 0; j < 4; ++j) h[n * 4 + j] = silu_f(acc[ai][0][m][n][j] * sc) * (acc[ai][1][m][n][j] * sc);
                int w0 = __builtin_amdgcn_cvt_pk_fp8_f32(h[0], h[1], 0, false); w0 = __builtin_amdgcn_cvt_pk_fp8_f32(h[2], h[3], w0, true);
                int w1 = __builtin_amdgcn_cvt_pk_fp8_f32(h[4], h[5], 0, false); w1 = __builtin_amdgcn_cvt_pk_fp8_f32(h[6], h[7], w1, true);
                u32x2 w; w.x = (unsigned)w0; w.y = (unsigned)w1; *(u32x2*)rowp = w; }
    }
};
struct EpiDown {
    static constexpr int PERM = 2;
    unsigned char* Y; const float* bufw; float sc;
    __device__ __forceinline__ void operator()(const f32x4 (&acc)[2][2][4][2], const Unit& u, int wr, int wc, int fr, int fq) const {
        const int row0 = u.pm * BM + wr * 64 + fr, col0 = (u.pn & 7) * BM + wc * 64 + 16 * fq;
#pragma unroll
        for (int ai = 0; ai < 2; ++ai)
#pragma unroll
            for (int m = 0; m < 4; ++m) { const int row = row0 + ai * HALF + m * 16; const float w8 = bufw[row] * sc; unsigned char* rowp = Y + (size_t)row * D + col0; int w[4];
#pragma unroll
                for (int bj = 0; bj < 2; ++bj)
#pragma unroll
                    for (int n = 0; n < 2; ++n) { const f32x4 v = acc[ai][bj][m][n] * w8;
                        int x = __builtin_amdgcn_cvt_pk_fp8_f32(v[0], v[1], 0, false); x = __builtin_amdgcn_cvt_pk_fp8_f32(v[2], v[3], x, true); w[bj * 2 + n] = x; }
                u32x4 o; o.x = (unsigned)w[0]; o.y = (unsigned)w[1]; o.z = (unsigned)w[2]; o.w = (unsigned)w[3]; *(u32x4*)rowp = o; }
    }
};
}

namespace att {
constexpr int NW = 8, QBLK = 32, KVBLK = 64;
constexpr int KRING = 8 * 4096, VRING = 12 * 8192;
constexpr int SHM_ATTN = KRING + VRING + NW * 64 * 4;
typedef int i32x8 __attribute__((ext_vector_type(8)));
typedef short s16x2 __attribute__((ext_vector_type(2)));
#define SBAR() __builtin_amdgcn_sched_barrier(0)
DI int crow(int r, int hi) { return (r & 3) + 8 * (r >> 2) + 4 * hi; }

template <int MAP>
DI void attn_pass(const unsigned char* __restrict__ Q8, const char* __restrict__ Kimg, const char* __restrict__ Vimg, bf16_t* __restrict__ Yb, u32x4* __restrict__ park, float lam, const float* __restrict__ sgv,
                  int NT, char* lds, LAS unsigned char* ldsl, int wv) {
    const int tid = opaque_tid(wv), wid = __builtin_amdgcn_readfirstlane(tid >> 6), lane = tid & 63, r32 = lane & 31, hi = lane >> 5;
    f32x16 o[4], o4; i32x8 B5, QF;
#pragma unroll
    for (int d = 0; d < 4; ++d)
#pragma unroll
        for (int r = 0; r < 16; ++r) o[d][r] = 0.f;
#pragma unroll
    for (int r = 0; r < 16; ++r) o4[r] = 0.f;
#pragma unroll
    for (int i = 0; i < 8; ++i) B5[i] = (r32 == 0 || r32 == 4) ? 0x38383838 : 0;
    { const u32x4 qa = *reinterpret_cast<const u32x4*>(Q8 + (size_t)(wid * QBLK + r32) * 1024 + hi * 32), qb = *reinterpret_cast<const u32x4*>(Q8 + (size_t)(wid * QBLK + r32) * 1024 + hi * 32 + 16);
      QF = (i32x8){(int)qa.x, (int)qa.y, (int)qa.z, (int)qa.w, (int)qb.x, (int)qb.y, (int)qb.z, (int)qb.w}; }
    asm volatile("s_waitcnt vmcnt(0)" ::: "memory");
    const unsigned goff = (unsigned)wid * 1024u + (unsigned)lane * 16u, ldsw = (unsigned)wid * 1024u, lds32 = (unsigned)(size_t)ldsl;
    const int sw = (r32 >> 2) & 3, vo0 = r32 * 64 + (((2 * hi) ^ sw) << 4), vo1 = r32 * 64 + (((2 * hi + 1) ^ sw) << 4);
    const bool kw = wid < 4;
#define DMAG(gp, m0v) asm volatile("s_nop 0\n\tglobal_load_lds_dwordx4 %0, %1" :: "v"(goff), "s"(gp), "{m0}"(m0v) : "memory")
#define DMA1(t, vs) do { \
    if (kw) DMAG(Kimg + (size_t)(t) * 4096, lds32 + (((unsigned)(t) & 7u) << 12) + ldsw); \
    DMAG(Vimg + (size_t)(t) * 8192, lds32 + (unsigned)KRING + ((unsigned)(vs) << 13) + ldsw); } while (0)
#define DMA4(t0, vs0) do { _Pragma("unroll") for (int _j = 0; _j < 4; ++_j) DMA1((t0) + _j, (vs0) + _j); } while (0)
#define KST(t) (lds + (((t) & 7) << 12))
#define VSTG(s) (lds + KRING + ((s) << 13))
#define LD16(p) (*reinterpret_cast<const u32x4*>(p))
#define MK8(va, vb) (i32x8){(int)va.x, (int)va.y, (int)va.z, (int)va.w, (int)vb.x, (int)vb.y, (int)vb.z, (int)vb.w}
#define M64(P, va, vb, d0) o[d0] = __builtin_amdgcn_mfma_scale_f32_32x32x64_f8f6f4(MK8(va, vb), P, o[d0], 0, 1, 0, 0, 0, 0)
#define MQK(ka, kb, acc) acc = __builtin_amdgcn_mfma_scale_f32_32x32x64_f8f6f4(MK8(ka, kb), QF, (f32x16){0.f, 0.f, 0.f, 0.f, 0.f, 0.f, 0.f, 0.f, 0.f, 0.f, 0.f, 0.f, 0.f, 0.f, 0.f, 0.f}, 0, 0, 0, 0, 0, 0)
#define PINF(x) asm volatile("" : "+v"(x))
#define EX1(S0, S1, e) do { if ((e) < 16) { S0[(e) & 15] = __builtin_amdgcn_exp2f(S0[(e) & 15]); PINF(S0[(e) & 15]); } else { S1[(e) & 15] = __builtin_amdgcn_exp2f(S1[(e) & 15]); PINF(S1[(e) & 15]); } } while (0)
#define EX4(S0, S1, e) do { EX1(S0, S1, e); EX1(S0, S1, (e) + 1); EX1(S0, S1, (e) + 2); EX1(S0, S1, (e) + 3); } while (0)
#define CVD(u) const int u = 0
#define CV2(a, b, c, d, dst, u) do { typedef __fp16 h2_t __attribute__((ext_vector_type(2))); const h2_t _x = __builtin_amdgcn_cvt_pkrtz(a, b), _y = __builtin_amdgcn_cvt_pkrtz(c, d); (void)u; \
    dst = (int)__builtin_amdgcn_perm(__builtin_bit_cast(unsigned, _y), __builtin_bit_cast(unsigned, _x), 0x07050301u); } while (0)
#define PIN6(PN) do { PINF(PN[0]); PINF(PN[1]); PINF(PN[2]); PINF(PN[3]); PINF(PN[4]); PINF(PN[5]); } while (0)
#define CVW(S0, S1, PN, i, u) do { if ((i) < 4) CV2(S0[(4 * (i)) & 15], S0[(4 * (i) + 1) & 15], S0[(4 * (i) + 2) & 15], S0[(4 * (i) + 3) & 15], PN[i], u); \
    else CV2(S1[(4 * (i)) & 15], S1[(4 * (i) + 1) & 15], S1[(4 * (i) + 2) & 15], S1[(4 * (i) + 3) & 15], PN[i], u); } while (0)
#define LOADK(t) do { const char* const _k = KST(t); ka0 = LD16(_k + vo0); ka1 = LD16(_k + vo1); kb0 = LD16(_k + 2048 + vo0); kb1 = LD16(_k + 2048 + vo1); } while (0)
#define ITER(DOQK, DOSM, DOPV, NXPV, NXQK, SN0, SN1, SP0, SP1, PN, PO, t, vstage, vnext) do { \
    u32x4 vc0, vc1, vd0, vd1; \
    const char* const vsb = VSTG(vstage); const char* const vsn = VSTG(vnext); const char* const ksn = KST((t) + 1); \
    SBAR(); \
    if (DOPV) M64(PO, va0, va1, 0); if (DOPV) { vc0 = LD16(vsb + 4096 + vo0); vc1 = LD16(vsb + 4096 + vo1); } if (DOSM) { EX4(SP0, SP1, 0); EX1(SP0, SP1, 4); EX1(SP0, SP1, 5); } \
    SBAR(); \
    if (DOPV) M64(PO, vb0, vb1, 1); if (DOPV) { vd0 = LD16(vsb + 6144 + vo0); vd1 = LD16(vsb + 6144 + vo1); } if (DOSM) { CVD(u0); EX4(SP0, SP1, 6); EX1(SP0, SP1, 10); EX1(SP0, SP1, 11); CVW(SP0, SP1, PN, 0, u0); } \
    SBAR(); \
    if (DOQK) { MQK(ka0, ka1, SN0); } if (NXPV) { va0 = LD16(vsn + vo0); va1 = LD16(vsn + vo1); } if (DOSM) { CVD(u1); CVD(u2); EX4(SP0, SP1, 12); CVW(SP0, SP1, PN, 1, u1); CVW(SP0, SP1, PN, 2, u2); } \
    SBAR(); \
    if (DOQK) { MQK(kb0, kb1, SN1); } if (NXPV) { vb0 = LD16(vsn + 2048 + vo0); vb1 = LD16(vsn + 2048 + vo1); } if (DOSM) { CVD(u3); EX4(SP0, SP1, 16); CVW(SP0, SP1, PN, 3, u3); } \
    SBAR(); \
    if (DOPV) M64(PO, vc0, vc1, 2); if (NXQK) { ka0 = LD16(ksn + vo0); ka1 = LD16(ksn + vo1); } if (DOSM) { CVD(u4); EX4(SP0, SP1, 20); CVW(SP0, SP1, PN, 4, u4); } \
    SBAR(); \
    if (DOPV) M64(PO, vd0, vd1, 3); if (NXQK) { kb0 = LD16(ksn + 2048 + vo0); kb1 = LD16(ksn + 2048 + vo1); } if (DOSM) { CVD(u5); EX4(SP0, SP1, 24); CVW(SP0, SP1, PN, 5, u5); } \
    SBAR(); \
    if (DOPV) o4 = __builtin_amdgcn_mfma_scale_f32_32x32x64_f8f6f4(B5, PO, o4, 0, 1, 0, 0, 0, 0); if (DOSM) { CVD(u6); CVD(u7); EX4(SP0, SP1, 28); CVW(SP0, SP1, PN, 6, u6); CVW(SP0, SP1, PN, 7, u7); PIN6(PN); } \
    SBAR(); } while (0)
#define ITERQ(DOQK, DOSM, DOPV, NXPV, NXQK, SN0, SN1, SP0, SP1, PN, PO, t, vstage, vnext) do { \
    u32x4 vc0, vc1, vd0, vd1; \
    const char* const vsb = VSTG(vstage); const char* const vsn = VSTG(vnext); const char* const ksn = KST((t) + 1); \
    SBAR(); \
    if (DOQK) { MQK(ka0, ka1, SN0); } if (DOPV) { vc0 = LD16(vsb + 4096 + vo0); vc1 = LD16(vsb + 4096 + vo1); } if (DOSM) { EX4(SP0, SP1, 0); EX1(SP0, SP1, 4); EX1(SP0, SP1, 5); } \
    SBAR(); \
    if (DOQK) { MQK(kb0, kb1, SN1); } if (DOPV) { vd0 = LD16(vsb + 6144 + vo0); vd1 = LD16(vsb + 6144 + vo1); } if (DOSM) { CVD(u0); EX4(SP0, SP1, 6); EX1(SP0, SP1, 10); EX1(SP0, SP1, 11); CVW(SP0, SP1, PN, 0, u0); } \
    SBAR(); \
    if (DOPV) M64(PO, va0, va1, 0); if (NXQK) { ka0 = LD16(ksn + vo0); ka1 = LD16(ksn + vo1); } if (DOSM) { CVD(u1); CVD(u2); EX4(SP0, SP1, 12); CVW(SP0, SP1, PN, 1, u1); CVW(SP0, SP1, PN, 2, u2); } \
    SBAR(); \
    if (DOPV) M64(PO, vb0, vb1, 1); if (NXQK) { kb0 = LD16(ksn + 2048 + vo0); kb1 = LD16(ksn + 2048 + vo1); } if (DOSM) { CVD(u3); EX4(SP0, SP1, 16); CVW(SP0, SP1, PN, 3, u3); } \
    SBAR(); \
    if (DOPV) M64(PO, vc0, vc1, 2); if (NXPV) { va0 = LD16(vsn + vo0); va1 = LD16(vsn + vo1); } if (DOSM) { CVD(u4); EX4(SP0, SP1, 20); CVW(SP0, SP1, PN, 4, u4); } \
    SBAR(); \
    if (DOPV) M64(PO, vd0, vd1, 3); if (NXPV) { vb0 = LD16(vsn + 2048 + vo0); vb1 = LD16(vsn + 2048 + vo1); } if (DOSM) { CVD(u5); EX4(SP0, SP1, 24); CVW(SP0, SP1, PN, 5, u5); } \
    SBAR(); \
    if (DOPV) o4 = __builtin_amdgcn_mfma_scale_f32_32x32x64_f8f6f4(B5, PO, o4, 0, 1, 0, 0, 0, 0); if (DOSM) { CVD(u6); CVD(u7); EX4(SP0, SP1, 28); CVW(SP0, SP1, PN, 6, u6); CVW(SP0, SP1, PN, 7, u7); PIN6(PN); } \
    SBAR(); } while (0)
    f32x16 SA0, SA1, SB0, SB1; i32x8 PE, PD;
#pragma unroll
    for (int i = 0; i < 8; ++i) { PE[i] = 0; PD[i] = 0; }
#define GROUP_SYNC(base, bn) do { asm volatile("s_waitcnt vmcnt(0)" ::: "memory"); __builtin_amdgcn_s_barrier(); LOADK(base); } while (0)
    u32x4 va0, va1, vb0, vb1, ka0, ka1, kb0, kb1;
    va0 = va1 = vb0 = vb1 = (u32x4){0u, 0u, 0u, 0u};
    DMA4(0, 0);
    GROUP_SYNC(0, 4);
    const bool more0 = 4 < NT;
    if (more0) DMA1(4, 4);
    ITER(true, false, false, false, true, SA0, SA1, SB0, SB1, PD, PE, 0, 0, 0);
    if (more0) DMA1(5, 5);
    ITERQ(true, true, false, true, true, SB0, SB1, SA0, SA1, PE, PD, 1, 0, 0);
    if (more0) { DMA1(6, 6); DMA1(7, 7); }
    ITERQ(true, true, true, true, true, SA0, SA1, SB0, SB1, PD, PE, 2, 0, 1);
    ITERQ(true, true, true, true, false, SB0, SB1, SA0, SA1, PE, PD, 3, 1, 2);
    int bp = 0, bm = 4, bn = 8;
    for (int base = 4; base < NT; base += 4) {
        GROUP_SYNC(base, bn);
        const bool more = base + 4 < NT;
        if (more) DMA1(base + 4, bn);
        ITER(true, true, true, true, true, SA0, SA1, SB0, SB1, PD, PE, base, bp + 2, bp + 3);
        if (more) DMA1(base + 5, bn + 1);
        ITERQ(true, true, true, true, true, SB0, SB1, SA0, SA1, PE, PD, base + 1, bp + 3, bm);
        if (more) { DMA1(base + 6, bn + 2); DMA1(base + 7, bn + 3); }
        ITERQ(true, true, true, true, true, SA0, SA1, SB0, SB1, PD, PE, base + 2, bm, bm + 1);
        ITERQ(true, true, true, true, false, SB0, SB1, SA0, SA1, PE, PD, base + 3, bm + 1, bm + 2);
        bp = bm; bm = bn; bn = (bn == 8) ? 0 : bn + 4;
    }
    ITER(false, true, true, true, false, SA0, SA1, SB0, SB1, PD, PE, NT, bp + 2, bp + 3);
    ITER(false, false, true, false, false, SB0, SB1, SA0, SA1, PE, PD, NT + 1, bp + 3, 0);
#undef GROUP_SYNC
#undef LOADK
    const float rl = __builtin_amdgcn_rcpf(o4[0]);
    if (MAP == 0) {
#pragma unroll
        for (int d0 = 0; d0 < 4; ++d0)
#pragma unroll
            for (int q = 0; q < 2; ++q) { u32x4 w;
                w.x = pk2(o[d0][8 * q + 0] * rl, o[d0][8 * q + 1] * rl); w.y = pk2(o[d0][8 * q + 2] * rl, o[d0][8 * q + 3] * rl);
                w.z = pk2(o[d0][8 * q + 4] * rl, o[d0][8 * q + 5] * rl); w.w = pk2(o[d0][8 * q + 6] * rl, o[d0][8 * q + 7] * rl);
                park[d0 * 2 + q] = w; }
    } else {
        float ss = 0.f; const float lrl = lam * rl;
#pragma unroll
        for (int d0 = 0; d0 < 4; ++d0)
#pragma unroll
            for (int q = 0; q < 2; ++q) { const u32x4 w = park[d0 * 2 + q]; const unsigned ww[4] = {w.x, w.y, w.z, w.w};
#pragma unroll
                for (int e = 0; e < 4; ++e) { const int r = 8 * q + 2 * e;
                    o[d0][r] = bflo(ww[e]) - lrl * o[d0][r]; o[d0][r + 1] = bfhi(ww[e]) - lrl * o[d0][r + 1];
                    ss += o[d0][r] * o[d0][r] + o[d0][r + 1] * o[d0][r + 1]; } }
        ss += __shfl_xor(ss, 32);
        const float rn = rsqrtf(ss * (1.0f / 128.0f) + EPS);
        bf16_t* Yw = Yb + (size_t)(wid * QBLK + r32) * D + 4 * hi;
#pragma unroll
        for (int d0 = 0; d0 < 4; ++d0)
#pragma unroll
            for (int j = 0; j < 4; ++j) { const f32x4 g = *(const f32x4*)(sgv + d0 * 32 + 8 * j + 4 * hi);
                u32x2 w; w.x = pk2(o[d0][4 * j] * rn * g[0], o[d0][4 * j + 1] * rn * g[1]); w.y = pk2(o[d0][4 * j + 2] * rn * g[2], o[d0][4 * j + 3] * rn * g[3]);
                *(u32x2*)(Yw + d0 * 32 + 8 * j) = w; }
    }
    __builtin_amdgcn_s_barrier();
#undef DMA4
#undef DMA1
#undef DMAG
#undef KST
#undef VSTG
#undef LD16
#undef MK8
#undef M64
#undef MQK
#undef EX1
#undef EX4
#undef PINF
#undef CVW
#undef PIN6
#undef CV2
#undef CVD
#undef ITER
#undef ITERQ
}
DI void attn_unit(const unsigned char* Q8m, const char* Kimgm, const char* Vimg, bf16_t* Yb, u32x4* park, float lam, const float* sgv, int NT, char* lds, LAS unsigned char* ldsl, int wv) {
    attn_pass<0>(Q8m, Kimgm, Vimg, Yb, park, lam, sgv, NT, lds, ldsl, wv);
    attn_pass<1>(Q8m + 64, Kimgm + (size_t)NTILE * 4096, Vimg, Yb, park, lam, sgv, NT, lds, ldsl, wv);
}
}

struct Args { const float* in[29]; float* out; unsigned char* ws; int ph_lo, ph_hi; };
struct Frame {
    const Args& a; size_t z; char* lds; int G, vcu, wv;
    DI const float* x() const { return a.in[0] + z; }
    DI const float* c() const { return a.in[1] + z; }
    DI const float* ctx() const { return a.in[2] + z; }
    DI const float* c_ctx() const { return a.in[3] + z; }
    DI const float* ada_w() const { return a.in[4] + z; }
    DI const float* ada_b() const { return a.in[5] + z; }
    DI const float* norm1_g() const { return a.in[6] + z; }
    DI const float* norm2_g() const { return a.in[7] + z; }
    DI const float* w_in() const { return a.in[8] + z; }
    DI const float* q_norm_g() const { return a.in[9] + z; }
    DI const float* k_norm_g() const { return a.in[10] + z; }
    DI const float* lam_q1() const { return a.in[11] + z; }
    DI const float* lam_k1() const { return a.in[12] + z; }
    DI const float* lam_q2() const { return a.in[13] + z; }
    DI const float* lam_k2() const { return a.in[14] + z; }
    DI const float* subln_g() const { return a.in[15] + z; }
    DI const float* pool_w() const { return a.in[16] + z; }
    DI const float* pool_scale() const { return a.in[17] + z; }
    DI const float* gmlp_norm_g() const { return a.in[18] + z; }
    DI const float* gmlp_ws() const { return a.in[19] + z; }
    DI const float* gmlp_bs() const { return a.in[20] + z; }
    DI const float* w_out() const { return a.in[21] + z; }
    DI const float* router_g_w() const { return a.in[22] + z; }
    DI const float* router_g_b() const { return a.in[23] + z; }
    DI const float* router_e_w() const { return a.in[24] + z; }
    DI const float* router_e_b() const { return a.in[25] + z; }
    DI const float* w_gate() const { return a.in[26] + z; }
    DI const float* w_up() const { return a.in[27] + z; }
    DI const float* w_down() const { return a.in[28] + z; }
    DI float* out() const { return a.out + z; }
    DI unsigned* ctl() const { return (unsigned*)(a.ws + z + WS_CTL); }
    DI float* MOD() const { return (float*)(a.ws + z + WS_MOD); }
    DI float* LAM() const { return (float*)(a.ws + z + WS_LAM); }
    DI float* ROPE() const { return (float*)(a.ws + z + WS_ROPE); }
    DI bf16_t* WSB() const { return (bf16_t*)(a.ws + z + WS_WSB); }
    DI bf16_t* PWT() const { return (bf16_t*)(a.ws + z + WS_PWT); }
    DI bf16_t* RWT() const { return (bf16_t*)(a.ws + z + WS_RWT); }
    DI bf16_t* WIN() const { return (bf16_t*)(a.ws + z + WS_WIN); }
    DI bf16_t* WOUT() const { return (bf16_t*)(a.ws + z + WS_WOUT); }
    DI bf16_t* GU() const { return (bf16_t*)(a.ws + z + WS_GU); }
    DI bf16_t* WD() const { return (bf16_t*)(a.ws + z + WS_WD); }
    DI bf16_t* ACT() const { return (bf16_t*)(a.ws + z + WS_ACT); }
    DI bf16_t* PROJ() const { return (bf16_t*)(a.ws + z + WS_PROJ); }
    DI unsigned char* PROJ8() const { return (unsigned char*)(a.ws + z + WS_PROJ); }
    DI bf16_t* PROJ16() const { return (bf16_t*)(a.ws + z + WS_PROJ + al256((size_t)TV * 3072)); }
    DI bf16_t* YBUF() const { return (bf16_t*)(a.ws + z + WS_PROJ); }
    DI bf16_t* HID() const { return (bf16_t*)(a.ws + z + WS_OPART + OFF_HID); }
    DI float* OPART() const { return (float*)(a.ws + z + WS_OPART); }
    DI float* LOGITS() const { return (float*)(a.ws + z + WS_OPART + OFF_LOGITS); }
    DI bf16_t* XB() const { return (bf16_t*)(a.ws + z + WS_XB); }
    DI float* ASGW() const { return (float*)(a.ws + z + WS_ASGW); }
    DI float* BUFW() const { return (float*)(a.ws + z + WS_BUFW); }
    DI int* ASGE() const { return (int*)(a.ws + z + WS_ASGE); }
    DI int* ASGP() const { return (int*)(a.ws + z + WS_ASGP); }
    DI int* SLOT() const { return (int*)(a.ws + z + WS_SLOT); }
    DI int* BUFT() const { return (int*)(a.ws + z + WS_BUFT); }
    DI int* BLKE() const { return (int*)(a.ws + z + WS_BLKE); }
    DI unsigned char* ACT8() const { return (unsigned char*)(a.ws + z + WS_OPART + OFF_ACT8); }
    DI unsigned char* Q8() const { return (unsigned char*)(a.ws + z + WS_Q8); }
    DI u32x4* PARK() const { return (u32x4*)(a.ws + z + WS_PARK); }
    DI char* KIMG() const { return (char*)(a.ws + z + WS_KIMG); }
    DI char* VIMG() const { return (char*)(a.ws + z + WS_VIMG); }
};

DI Frame fresh(const Frame& F) {
    size_t z = 0; int g = F.G, v = F.vcu, w = F.wv;
    asm volatile("" : "+s"(z), "+s"(g), "+s"(v), "+s"(w));
    return Frame{F.a, z, F.lds, g, v, w};
}
DI bool row_isctx(int r) { const int j = r >= SEQV ? r - SEQV : r; return j < CTX; }
DI size_t row_off(int r, bool& isctx, int& b) { b = r >= SEQV; const int j = r - b * SEQV; isctx = j < CTX; return isctx ? (size_t)(b * CTX + j) * D : (size_t)(b * SEQ + j - CTX) * D; }

struct TileD { const float* sp; char* dp; float scale; int is8; };
DI TileD tile_desc(const Frame& F, int u, int t) {
    constexpr int C0 = 2 * 32 * 72, C1 = C0 + 2 * 32 * 32, C2 = C1 + 64 * 256, C3 = C2 + 64 * 256, C4 = C3 + 64 * 256;
    const float* src; char* dst; int ldsrc, lddst, k0, n0, drow0, is8 = 1; float scale = 32.0f;
    if (u < C0) { const int l = u / 2304, r = u % 2304, kt = r / 72, nt = r % 72;
        src = F.w_in() + (size_t)l * D * INC; ldsrc = INC; dst = (char*)F.WIN() + (size_t)l * INC * D; lddst = D; k0 = kt * 64; n0 = nt * 64; drow0 = n0; }
    else if (u < C1) { const int v = u - C0, l = v / 1024, r = v % 1024, kt = r / 32, nt = r % 32;
        src = F.w_out() + (size_t)l * D * D; ldsrc = D; dst = (char*)(F.WOUT() + (size_t)l * D * D); lddst = D; k0 = kt * 64; n0 = nt * 64; drow0 = n0; is8 = 0; }
    else if (u < C3) { const bool up = u >= C2; const int v = u - (up ? C2 : C1), le = v / 256, r = v % 256, kt = r / 8, nt = r % 8;
        src = (up ? F.w_up() : F.w_gate()) + (size_t)le * D * FF; ldsrc = FF; dst = (char*)F.GU() + (size_t)le * 1024 * D; lddst = D; k0 = kt * 64; n0 = nt * 64; drow0 = (n0 >> 7) * 256 + (up ? 128 : 0) + (n0 & 127); }
    else if (u < C4) { const int v = u - C3, le = v / 256, r = v % 256, kt = r / 32, nt = r % 32;
        src = F.w_down() + (size_t)le * FF * D; ldsrc = D; dst = (char*)F.WD() + (size_t)le * D * FF; lddst = FF; k0 = kt * 64; n0 = nt * 64; drow0 = n0; scale = 16.0f; }
    else { const int v = u - C4, lg = v / 4, r = v % 4, kt = r / 2, nt = r % 2;
        src = F.pool_w() + (size_t)lg * 128 * 128; ldsrc = 128; dst = (char*)(F.PWT() + (size_t)lg * 128 * 128); lddst = 128; k0 = kt * 64; n0 = nt * 64; drow0 = n0; is8 = 0; }
    const int hi = t >> 3, lo8 = (t & 7) * 8;
    TileD d; d.sp = src + (size_t)(k0 + hi) * ldsrc + n0 + lo8; d.dp = dst + ((size_t)(drow0 + hi) * lddst + k0 + lo8) * (is8 ? 1 : 2); d.scale = scale; d.is8 = is8;
    return d;
}
DI void tile_process(const Frame& F, int t, const TileD& d, f32x4 a, f32x4 b) {
    const int kr = t >> 3, nc = (t & 7) * 8;
    if (d.is8) {
        unsigned char* T = (unsigned char*)F.lds;
        a *= d.scale; b *= d.scale;
        const unsigned p0 = (unsigned)__builtin_amdgcn_cvt_pk_fp8_f32(a[0], a[1], 0, false), p1 = (unsigned)__builtin_amdgcn_cvt_pk_fp8_f32(a[2], a[3], 0, false);
        const unsigned p2 = (unsigned)__builtin_amdgcn_cvt_pk_fp8_f32(b[0], b[1], 0, false), p3 = (unsigned)__builtin_amdgcn_cvt_pk_fp8_f32(b[2], b[3], 0, false);
        T[(nc + 0) * 72 + kr] = (unsigned char)p0; T[(nc + 1) * 72 + kr] = (unsigned char)(p0 >> 8); T[(nc + 2) * 72 + kr] = (unsigned char)p1; T[(nc + 3) * 72 + kr] = (unsigned char)(p1 >> 8);
        T[(nc + 4) * 72 + kr] = (unsigned char)p2; T[(nc + 5) * 72 + kr] = (unsigned char)(p2 >> 8); T[(nc + 6) * 72 + kr] = (unsigned char)p3; T[(nc + 7) * 72 + kr] = (unsigned char)(p3 >> 8);
        __syncthreads();
        const u32x2 w = *(const u32x2*)(T + kr * 72 + nc);
        *(u32x2*)d.dp = w;
        __syncthreads();
    } else {
        bf16_t* T = (bf16_t*)F.lds;
        const unsigned p0 = pk2(a[0], a[1]), p1 = pk2(a[2], a[3]), p2 = pk2(b[0], b[1]), p3 = pk2(b[2], b[3]);
        T[(nc + 0) * 66 + kr] = (bf16_t)p0; T[(nc + 1) * 66 + kr] = (bf16_t)(p0 >> 16); T[(nc + 2) * 66 + kr] = (bf16_t)p1; T[(nc + 3) * 66 + kr] = (bf16_t)(p1 >> 16);
        T[(nc + 4) * 66 + kr] = (bf16_t)p2; T[(nc + 5) * 66 + kr] = (bf16_t)(p2 >> 16); T[(nc + 6) * 66 + kr] = (bf16_t)p3; T[(nc + 7) * 66 + kr] = (bf16_t)(p3 >> 16);
        __syncthreads();
        const unsigned* Tw = (const unsigned*)(T + kr * 66 + nc);
        u32x4 w; w.x = Tw[0]; w.y = Tw[1]; w.z = Tw[2]; w.w = Tw[3];
        *(u32x4*)d.dp = w;
        __syncthreads();
    }
}
DI void phase_prologue(const Frame& F) {
    const int t = opaque_tid(F.wv), bx = blockIdx.x, G = F.G;
    {
        constexpr int C5 = 2 * 32 * 72 + 2 * 32 * 32 + 3 * 64 * 256 + 32;
        TileD d0 = tile_desc(F, bx < C5 ? bx : 0, t), d1 = tile_desc(F, bx + G < C5 ? bx + G : 0, t);
        f32x4 a0 = *(const f32x4*)d0.sp, b0 = *(const f32x4*)(d0.sp + 4), a1 = *(const f32x4*)d1.sp, b1 = *(const f32x4*)(d1.sp + 4);
        for (int u = bx; u < C5; u += G) {
            const int u2 = u + 2 * G;
            const TileD d2 = tile_desc(F, u2 < C5 ? u2 : 0, t);
            const f32x4 a2 = *(const f32x4*)d2.sp, b2 = *(const f32x4*)(d2.sp + 4);
            tile_process(F, t, d0, a0, b0);
            d0 = d1; a0 = a1; b0 = b1; d1 = d2; a1 = a2; b1 = b2;
        }
    }
    {
        float* sv = (float*)F.lds;
        float* red = sv + 3 * D;
        __syncthreads();
        for (int i = t; i < 3 * D; i += 512) { const int v = i / D, k = i % D; const float cv = v < 2 ? F.c()[v * D + k] : F.c_ctx()[k]; sv[i] = silu_f(cv); }
        __syncthreads();
        const int cg = t & 7, kl = t >> 3;
        for (int u = bx; u < 768; u += G) {
            const int l = u / 384, n0 = (u % 384) * 32;
            const float* W = F.ada_w() + (size_t)l * D * 6 * D + n0 + cg * 4;
            f32x4 a0 = {0, 0, 0, 0}, a1 = a0, a2 = a0;
#pragma unroll 8
            for (int k = kl; k < D; k += 64) { const f32x4 w = *(const f32x4*)(W + (size_t)k * 6 * D); a0 += w * sv[k]; a1 += w * sv[D + k]; a2 += w * sv[2 * D + k]; }
            float* rp = red + (kl * 8 + cg) * 12;
            *(f32x4*)(rp) = a0; *(f32x4*)(rp + 4) = a1; *(f32x4*)(rp + 8) = a2;
            __syncthreads();
            if (t < 96) { const int v = t / 32, cc = t % 32, cgg = cc >> 2, j = cc & 3; float s = 0.f;
                for (int q = 0; q < 64; ++q) s += red[(q * 8 + cgg) * 12 + v * 4 + j];
                F.MOD()[((size_t)l * 3 + v) * 6 * D + n0 + cc] = s + F.ada_b()[(size_t)l * 6 * D + n0 + cc]; }
            __syncthreads();
        }
    }
    const int gt = bx * 512 + t, GT = G * 512;
    for (int i = gt; i < 2 * 4 * 128 * 128; i += GT) F.WSB()[i] = (bf16_t)pk2(F.gmlp_ws()[i], 0.f);
    for (int i = gt; i < 256 * 16; i += GT) { const int pos = i >> 4, k = i & 15; const float inv = powf(10000.0f, -(float)k / 16.0f); const float ang = (float)pos * inv;
        F.ROPE()[i] = cosf(ang); F.ROPE()[256 * 16 + i] = sinf(ang); }
    for (int i = gt; i < 2 * 256 * D; i += GT) { const int l = i / (256 * D), r = (i / D) % 256, k = i % D; float v = 0.f;
        if (r < 4) v = F.router_g_w()[((size_t)l * D + k) * 4 + r]; else if (r < 36) v = F.router_e_w()[((size_t)l * D + k) * 32 + (r - 4)];
        F.RWT()[i] = (bf16_t)pk2(v, 0.f); }
    if (bx == 0 && t < 128) {
        const int l = t >> 6, k = t & 63;
        const float s1 = wave_sum(F.lam_q1()[l * 64 + k] * F.lam_k1()[l * 64 + k]), s2 = wave_sum(F.lam_q2()[l * 64 + k] * F.lam_k2()[l * 64 + k]);
        if (k == 0) F.LAM()[l] = expf(s1) - expf(s2) + (l == 0 ? 0.2f : 0.8f - 0.6f * 0.7408182206817179f);
    }
}

DI float sumsq8(const f32x4 (&v)[8]) {
    float ss = 0.f;
#pragma unroll
    for (int i = 0; i < 8; ++i) ss += v[i][0] * v[i][0] + v[i][1] * v[i][1] + v[i][2] * v[i][2] + v[i][3] * v[i][3];
    return ss;
}
DI int CI8(int lane, int i) { return (i >> 1) * 512 + lane * 8 + (i & 1) * 4; }
DI void ysum8(const unsigned char* y0, const unsigned char* y1, int cidx, f32x4& lo, f32x4& hi) {
    typedef float f2 __attribute__((ext_vector_type(2)));
    const u32x2 a = *(const u32x2*)(y0 + cidx), bb = *(const u32x2*)(y1 + cidx);
    const f2 a0 = __builtin_amdgcn_cvt_pk_f32_fp8(a.x, false), a1 = __builtin_amdgcn_cvt_pk_f32_fp8(a.x, true), a2 = __builtin_amdgcn_cvt_pk_f32_fp8(a.y, false), a3 = __builtin_amdgcn_cvt_pk_f32_fp8(a.y, true);
    const f2 b0 = __builtin_amdgcn_cvt_pk_f32_fp8(bb.x, false), b1 = __builtin_amdgcn_cvt_pk_f32_fp8(bb.x, true), b2 = __builtin_amdgcn_cvt_pk_f32_fp8(bb.y, false), b3 = __builtin_amdgcn_cvt_pk_f32_fp8(bb.y, true);
    lo = (f32x4){a0[0] + b0[0], a0[1] + b0[1], a1[0] + b1[0], a1[1] + b1[1]}; hi = (f32x4){a2[0] + b2[0], a2[1] + b2[1], a3[0] + b3[0], a3[1] + b3[1]};
}
DI void unpack8(const u32x4 w, f32x4& lo, f32x4& hi) { lo = (f32x4){bflo(w.x), bfhi(w.x), bflo(w.y), bfhi(w.y)}; hi = (f32x4){bflo(w.z), bfhi(w.z), bflo(w.w), bfhi(w.w)}; }
DI u32x4 pack8(const f32x4 lo, const f32x4 hi) { u32x4 w; w.x = pk2(lo[0], lo[1]); w.y = pk2(lo[2], lo[3]); w.z = pk2(hi[0], hi[1]); w.w = pk2(hi[2], hi[3]); return w; }
DI u32x2 pack8f8(const f32x4 lo, const f32x4 hi) { int a = __builtin_amdgcn_cvt_pk_fp8_f32(lo[0], lo[1], 0, false); a = __builtin_amdgcn_cvt_pk_fp8_f32(lo[2], lo[3], a, true);
    int b = __builtin_amdgcn_cvt_pk_fp8_f32(hi[0], hi[1], 0, false); b = __builtin_amdgcn_cvt_pk_fp8_f32(hi[2], hi[3], b, true); u32x2 w; w.x = (unsigned)a; w.y = (unsigned)b; return w; }
template <int L> DI void phase_norm1(const Frame& F) {
    constexpr int NR = 2;
    const int tid = opaque_tid(F.wv), wave = tid >> 6, lane = tid & 63;
    const float* gN = F.norm1_g() + (size_t)L * D;
    int sl[NR][2];
#pragma unroll
    for (int q = 0; q < NR; ++q) { sl[q][0] = 0; sl[q][1] = 0; }
    if (L == 1) { const int r0 = (blockIdx.x * 8 + wave) * NR; if (r0 < TV) {
#pragma unroll
        for (int q = 0; q < NR; ++q) { sl[q][0] = F.SLOT()[(r0 + q) * 2]; sl[q][1] = F.SLOT()[(r0 + q) * 2 + 1]; } } }
    for (int r0 = (blockIdx.x * 8 + wave) * NR; r0 < TV; r0 += F.G * 8 * NR) {
        bool isctx; int b; const size_t off = row_off(r0, isctx, b);
        const float* m = F.MOD() + ((size_t)L * 3 + (isctx ? 2 : b)) * 6 * D;
        int sn[NR][2];
#pragma unroll
        for (int q = 0; q < NR; ++q) { sn[q][0] = 0; sn[q][1] = 0; }
        if (L == 1) { const int rn = r0 + F.G * 8 * NR; if (rn < TV) {
#pragma unroll
            for (int q = 0; q < NR; ++q) { sn[q][0] = F.SLOT()[(rn + q) * 2]; sn[q][1] = F.SLOT()[(rn + q) * 2 + 1]; } } }
        f32x4 v[NR][8];
        bf16_t* xb = F.XB() + (size_t)r0 * D;
        if (L == 0) { const float* xin = (isctx ? F.ctx() : F.x()) + off;
#pragma unroll
            for (int q = 0; q < NR; ++q)
#pragma unroll
                for (int i = 0; i < 8; ++i) v[q][i] = *(const f32x4*)(xin + (size_t)q * D + CI8(lane, i));
        } else {
            const float* g2 = F.MOD() + ((size_t)0 * 3 + (isctx ? 2 : b)) * 6 * D + 5 * D;
            f32x4 yy[NR][8];
#pragma unroll
            for (int q = 0; q < NR; ++q) { const int s0 = sl[q][0], s1 = sl[q][1];
                const unsigned char* y0 = (const unsigned char*)F.YBUF() + (size_t)s0 * D; const unsigned char* y1 = (const unsigned char*)F.YBUF() + (size_t)s1 * D;
#pragma unroll
                for (int k = 0; k < 4; ++k) { const int cidx = CI8(lane, 2 * k); unpack8(*(const u32x4*)(xb + (size_t)q * D + cidx), v[q][2 * k], v[q][2 * k + 1]); ysum8(y0, y1, cidx, yy[q][2 * k], yy[q][2 * k + 1]); } }
#pragma unroll
            for (int i = 0; i < 8; ++i) { const f32x4 gg = *(const f32x4*)(g2 + CI8(lane, i));
#pragma unroll
                for (int q = 0; q < NR; ++q) v[q][i] = v[q][i] + gg * yy[q][i]; }
        }
#pragma unroll
        for (int q = 0; q < NR; ++q)
#pragma unroll
            for (int k = 0; k < 4; ++k) *(u32x4*)(xb + (size_t)q * D + CI8(lane, 2 * k)) = pack8(v[q][2 * k], v[q][2 * k + 1]);
        float rs[NR];
#pragma unroll
        for (int q = 0; q < NR; ++q) rs[q] = sumsq8(v[q]);
#pragma unroll
        for (int o = 32; o >= 1; o >>= 1)
#pragma unroll
            for (int q = 0; q < NR; ++q) rs[q] += __shfl_xor(rs[q], o);
#pragma unroll
        for (int q = 0; q < NR; ++q) rs[q] = rsqrtf(rs[q] * (1.0f / D) + EPS);
        unsigned char* hp = (unsigned char*)F.ACT() + (size_t)r0 * D;
#pragma unroll
        for (int k = 0; k < 4; ++k) { const int cidx = CI8(lane, 2 * k);
            const f32x4 gn0 = *(const f32x4*)(gN + cidx), sh0 = *(const f32x4*)(m + cidx), sc0 = (*(const f32x4*)(m + D + cidx) + 1.0f) * gn0;
            const f32x4 gn1 = *(const f32x4*)(gN + cidx + 4), sh1 = *(const f32x4*)(m + cidx + 4), sc1 = (*(const f32x4*)(m + D + cidx + 4) + 1.0f) * gn1;
#pragma unroll
            for (int q = 0; q < NR; ++q) *(u32x2*)(hp + (size_t)q * D + cidx) = pack8f8(v[q][2 * k] * rs[q] * sc0 + sh0, v[q][2 * k + 1] * rs[q] * sc1 + sh1); }
#pragma unroll
        for (int q = 0; q < NR; ++q) { sl[q][0] = sn[q][0]; sl[q][1] = sn[q][1]; }
    }
}

DI void phase_norm2r(const Frame& F, int l) {
    constexpr int NR = 2, HP = 2056, NG = TV / 16;
    const int tid = opaque_tid(F.wv), wave = tid >> 6, lane = tid & 63, fr = lane & 15, fq = lane >> 4;
    const float* gN = F.norm2_g() + (size_t)l * D;
    for (int i = blockIdx.x * 512 + tid; i < NSLOT_MAX; i += F.G * 512) { F.BUFT()[i] = -1; F.BUFW()[i] = 0.f; }
    bf16_t* Ht = (bf16_t*)F.lds;
    float* PART = (float*)(F.lds + 66048);
    float* LOG = (float*)(F.lds + 66048 + 24576);
    bf16_t* GW = (bf16_t*)(F.lds + 66048 + 24576 + 3072);
    bf16x8 Bf[2][8];
    { const bf16_t* rw = F.RWT() + ((size_t)l * 256 + 4 + fr) * D + 256 * wave + 8 * fq;
#pragma unroll
      for (int nt = 0; nt < 2; ++nt)
#pragma unroll
          for (int ks = 0; ks < 8; ++ks) Bf[nt][ks] = *(const bf16x8*)(rw + (size_t)(16 * nt) * D + 32 * ks);
      for (int c = tid; c < 5 * 256; c += 512) { const int row = c >> 8, col = (c & 255) * 8;
          u32x4 w = (u32x4){0u, 0u, 0u, 0u}; if (row < 4) w = *(const u32x4*)(F.RWT() + ((size_t)l * 256 + row) * D + col);
          *(u32x4*)(GW + (size_t)row * HP + col) = w; } }
    const bf16_t* gwp = GW + (size_t)(fr < 4 ? fr : 4) * HP + 256 * wave + 8 * fq;
    int* lcnt = (int*)(F.lds + 114304);
    if (tid < 32) lcnt[tid] = 0;
    const float* gb = F.router_g_b() + l * 4; const float* eb = F.router_e_b() + l * 32;
    int g = blockIdx.x;
    while (g < NG && l == 1 && row_isctx(g * 16)) g += F.G;
    u32x4 raw[NR][4];
#pragma unroll
    for (int q = 0; q < NR; ++q)
#pragma unroll
        for (int i = 0; i < 4; ++i) raw[q][i] = (u32x4){0u, 0u, 0u, 0u};
    if (g < NG) { const bf16_t* xb = F.XB() + (size_t)(g * 16 + 2 * wave) * D;
#pragma unroll
        for (int q = 0; q < NR; ++q)
#pragma unroll
            for (int i = 0; i < 4; ++i) raw[q][i] = *(const u32x4*)(xb + (size_t)q * D + CI8(lane, 2 * i)); }
    while (g < NG) {
        const int r0 = g * 16 + 2 * wave;
        bool isctx; int b; row_off(r0, isctx, b);
        const float* m = F.MOD() + ((size_t)l * 3 + (isctx ? 2 : b)) * 6 * D;
        int gn = g + F.G;
        while (gn < NG && l == 1 && row_isctx(gn * 16)) gn += F.G;
        float rs[NR];
#pragma unroll
        for (int q = 0; q < NR; ++q) { float ss = 0.f;
#pragma unroll
            for (int i = 0; i < 4; ++i) { f32x4 a, c; unpack8(raw[q][i], a, c); ss += a[0] * a[0] + a[1] * a[1] + a[2] * a[2] + a[3] * a[3] + c[0] * c[0] + c[1] * c[1] + c[2] * c[2] + c[3] * c[3]; }
            rs[q] = ss; }
#pragma unroll
        for (int o = 32; o >= 1; o >>= 1)
#pragma unroll
            for (int q = 0; q < NR; ++q) rs[q] += __shfl_xor(rs[q], o);
#pragma unroll
        for (int q = 0; q < NR; ++q) rs[q] = rsqrtf(rs[q] * (1.0f / D) + EPS);
        unsigned char* h8 = F.ACT8() + (size_t)r0 * D;
#pragma unroll
        for (int k = 0; k < 4; ++k) { const int cidx = CI8(lane, 2 * k);
            const f32x4 gn0 = *(const f32x4*)(gN + cidx), sh0 = *(const f32x4*)(m + 3 * D + cidx), sc0 = (*(const f32x4*)(m + 4 * D + cidx) + 1.0f) * gn0;
            const f32x4 gn1 = *(const f32x4*)(gN + cidx + 4), sh1 = *(const f32x4*)(m + 3 * D + cidx + 4), sc1 = (*(const f32x4*)(m + 4 * D + cidx + 4) + 1.0f) * gn1;
#pragma unroll
            for (int q = 0; q < NR; ++q) { f32x4 xa, xc; unpack8(raw[q][k], xa, xc); const f32x4 h0 = xa * rs[q] * sc0 + sh0, h1 = xc * rs[q] * sc1 + sh1;
                *(u32x4*)(Ht + (size_t)(2 * wave + q) * HP + cidx) = pack8(h0, h1); *(u32x2*)(h8 + (size_t)q * D + cidx) = pack8f8(h0, h1); } }
        __syncthreads();
        if (gn < NG) { const bf16_t* xb = F.XB() + (size_t)(gn * 16 + 2 * wave) * D;
#pragma unroll
            for (int q = 0; q < NR; ++q)
#pragma unroll
                for (int i = 0; i < 4; ++i) raw[q][i] = *(const u32x4*)(xb + (size_t)q * D + CI8(lane, 2 * i)); }
        f32x4 acc[3];
#pragma unroll
        for (int nt = 0; nt < 3; ++nt) acc[nt] = (f32x4){0.f, 0.f, 0.f, 0.f};
#pragma unroll
        for (int ks = 0; ks < 8; ++ks) { const bf16x8 A = *(const bf16x8*)(Ht + (size_t)fr * HP + 256 * wave + 32 * ks + 8 * fq); const bf16x8 Bg = *(const bf16x8*)(gwp + 32 * ks);
#pragma unroll
            for (int nt = 0; nt < 2; ++nt) acc[nt] = __builtin_amdgcn_mfma_f32_16x16x32_bf16(A, Bf[nt][ks], acc[nt], 0, 0, 0);
            acc[2] = __builtin_amdgcn_mfma_f32_16x16x32_bf16(A, Bg, acc[2], 0, 0, 0); }
#pragma unroll
        for (int nt = 0; nt < 3; ++nt)
#pragma unroll
            for (int jj = 0; jj < 4; ++jj) PART[(wave * 16 + 4 * fq + jj) * 48 + 16 * nt + fr] = acc[nt][jj];
        __syncthreads();
        for (int p = tid; p < 768; p += 512) { float sacc = 0.f;
#pragma unroll
            for (int w = 0; w < 8; ++w) sacc += PART[w * 768 + p];
            LOG[p] = sacc; }
        __syncthreads();
        if (tid < 16) {
            const int tok = g * 16 + tid; const float* L = LOG + tid * 48;
            float gl[4]; const f32x4 g4 = *(const f32x4*)(L + 32);
#pragma unroll
            for (int i = 0; i < 4; ++i) gl[i] = g4[i] + gb[i];
            int gi = 0; float gm = gl[0];
#pragma unroll
            for (int i = 1; i < 4; ++i) if (gl[i] > gm) { gm = gl[i]; gi = i; }
            float gs = 0.f;
#pragma unroll
            for (int i = 0; i < 4; ++i) gs += expf(gl[i] - gm);
            const float gval = 1.0f / gs;
            float el[8]; const f32x4 ea = *(const f32x4*)(L + gi * 8), ebv = *(const f32x4*)(L + 4 + gi * 8);
#pragma unroll
            for (int i = 0; i < 4; ++i) { el[i] = ea[i] + eb[gi * 8 + i]; el[4 + i] = ebv[i] + eb[gi * 8 + 4 + i]; }
            int i0 = 0; float m0 = el[0];
#pragma unroll
            for (int i = 1; i < 8; ++i) if (el[i] > m0) { m0 = el[i]; i0 = i; }
            int i1 = -1; float m1 = -3.0e38f;
#pragma unroll
            for (int i = 0; i < 8; ++i) if (i != i0 && el[i] > m1) { m1 = el[i]; i1 = i; }
            const float x1 = expf(m1 - m0), den = 1.0f / (1.0f + x1);
            const int e0 = gi * 8 + i0, e1 = gi * 8 + i1;
            F.ASGE()[tok * 2] = e0; F.ASGE()[tok * 2 + 1] = e1;
            F.ASGW()[tok * 2] = gval * den; F.ASGW()[tok * 2 + 1] = gval * x1 * den;
            F.ASGP()[tok * 2] = atomicAdd(&lcnt[e0], 1); F.ASGP()[tok * 2 + 1] = atomicAdd(&lcnt[e1], 1);
        }
        g = gn;
    }
    __syncthreads();
    if (tid < 32) ((int*)F.LOGITS())[blockIdx.x * 32 + tid] = lcnt[tid];
}

DI void phase_final(const Frame& F) {
    constexpr int NR = 2;
    const int tid = opaque_tid(F.wv), wave = tid >> 6, lane = tid & 63;
    int sl[NR][2];
#pragma unroll
    for (int q = 0; q < NR; ++q) { sl[q][0] = 0; sl[q][1] = 0; }
    { const int r0 = (blockIdx.x * 8 + wave) * NR; if (r0 < TV) {
#pragma unroll
        for (int q = 0; q < NR; ++q) { sl[q][0] = F.SLOT()[(r0 + q) * 2]; sl[q][1] = F.SLOT()[(r0 + q) * 2 + 1]; } } }
    for (int r0 = (blockIdx.x * 8 + wave) * NR; r0 < TV; r0 += F.G * 8 * NR) {
        bool isctx; int b; const size_t off = row_off(r0, isctx, b);
        int scur[NR][2];
#pragma unroll
        for (int q = 0; q < NR; ++q) { scur[q][0] = sl[q][0]; scur[q][1] = sl[q][1]; }
        { const int rn = r0 + F.G * 8 * NR; if (rn < TV) {
#pragma unroll
            for (int q = 0; q < NR; ++q) { sl[q][0] = F.SLOT()[(rn + q) * 2]; sl[q][1] = F.SLOT()[(rn + q) * 2 + 1]; } } }
        if (isctx) continue;
        float* xp = F.out() + off; const bf16_t* xb = F.XB() + (size_t)r0 * D;
        const float* g2 = F.MOD() + ((size_t)1 * 3 + b) * 6 * D + 5 * D;
        f32x4 v[NR][8], yy[NR][8];
#pragma unroll
        for (int q = 0; q < NR; ++q) { const int s0 = scur[q][0], s1 = scur[q][1];
            const unsigned char* y0 = (const unsigned char*)F.YBUF() + (size_t)s0 * D; const unsigned char* y1 = (const unsigned char*)F.YBUF() + (size_t)s1 * D;
#pragma unroll
            for (int k = 0; k < 4; ++k) { const int cidx = CI8(lane, 2 * k); unpack8(*(const u32x4*)(xb + (size_t)q * D + cidx), v[q][2 * k], v[q][2 * k + 1]); ysum8(y0, y1, cidx, yy[q][2 * k], yy[q][2 * k + 1]); } }
#pragma unroll
        for (int i = 0; i < 8; ++i) { const int cidx = CI8(lane, i); const f32x4 gg = *(const f32x4*)(g2 + cidx);
#pragma unroll
            for (int q = 0; q < NR; ++q) *(f32x4*)(xp + (size_t)q * D + cidx) = v[q][i] + gg * yy[q][i]
                ; }
    }
}

DI void phase_slots(const Frame& F, int l) {
    const int tid = opaque_tid(F.wv), bx = blockIdx.x, G = F.G;
    int* ptot = (int*)F.lds; int* pbel = ptot + 512; int* tot = pbel + 512; int* bel = tot + 32; int* pstart = bel + 32; int* nb = pstart + 32;
    const int* CNTM = (const int*)F.LOGITS();
    __syncthreads();
    { const int e = tid & 31, part = tid >> 5; int st = 0, sb = 0;
      for (int w = part; w < G; w += 16) { const int c = CNTM[w * 32 + e]; st += c; if (w < bx) sb += c; }
      ptot[part * 32 + e] = st; pbel[part * 32 + e] = sb; }
    __syncthreads();
    if (tid < 32) { int st = 0, sb = 0;
#pragma unroll
        for (int q = 0; q < 16; ++q) { st += ptot[q * 32 + tid]; sb += pbel[q * 32 + tid]; }
        tot[tid] = st; bel[tid] = sb; }
    __syncthreads();
    if (tid == 0) { int acc = 0;
        for (int e = 0; e < NEXP; ++e) { pstart[e] = acc; acc += (tot[e] + 255) & ~255; }
        nb[0] = acc >> 8; }
    __syncthreads();
    if (bx == 0) { const int nblk = nb[0];
        for (int bb = tid; bb < nblk; bb += 512) { int e = 0;
#pragma unroll
            for (int q = 1; q < NEXP; ++q) if (pstart[q] <= bb * 256) e = q;
            F.BLKE()[bb] = e; }
        if (tid == 0) F.BLKE()[NBLK_MAX] = nblk; }
    for (int kk = tid >> 5; bx + kk * G < TV / 16; kk += 16) {
        const int g = bx + kk * G;
        if (l == 1 && row_isctx(g * 16)) continue;
        const int i = g * 32 + (tid & 31);
        const int e = F.ASGE()[i], slot = pstart[e] + bel[e] + F.ASGP()[i];
        F.BUFT()[slot] = i >> 1; F.BUFW()[slot] = F.ASGW()[i]; F.SLOT()[i] = slot;
    }
}

constexpr int vperm(int c) { return 16 * (2 * ((c >> 5) & 3) + ((c >> 2) & 1)) + 4 * ((c >> 3) & 3) + (c & 3); }
DI void mixer_unit(const Frame& F, int l, int cidx, int glo, int ghi) {
    const int tid = opaque_tid(F.wv), wid = tid >> 6, lane = tid & 63, fr = lane & 15, fq = lane >> 4;
    const int row0 = cidx * 128, b = row0 >= SEQV, j0 = row0 - b * SEQV; const bool isctx = j0 < CTX;
    const int slo = b * SEQV + (isctx ? 0 : CTX), nseq = isctx ? CTX : SEQ;
    bf16_t* Vt = (bf16_t*)F.lds;
    constexpr int VP = 136;
    {
        const int tk = tid >> 2, qd = tid & 3;
        const bf16_t* vp = F.PROJ16() + (size_t)(row0 + tk) * 1536 + (GV_OFF - POOL_OFF) + qd * 128;
        const float* ng = F.gmlp_norm_g() + (size_t)l * 512 + qd * 128;
        u32x4 raw[16]; unsigned gp[64];
#pragma unroll
        for (int i = 0; i < 16; ++i) raw[i] = *(const u32x4*)(vp + 8 * i);
        float s = 0.f, s2 = 0.f;
#pragma unroll
        for (int i = 0; i < 16; ++i) { const unsigned ww[4] = {raw[i].x, raw[i].y, raw[i].z, raw[i].w};
#pragma unroll
            for (int e = 0; e < 4; ++e) { const float g0 = gelu_tanh(bflo(ww[e])), g1 = gelu_tanh(bfhi(ww[e])); s += g0 + g1; s2 += g0 * g0 + g1 * g1; gp[4 * i + e] = pk2(g0, g1); } }
        s += __shfl_xor(s, 1); s += __shfl_xor(s, 2); s2 += __shfl_xor(s2, 1); s2 += __shfl_xor(s2, 2);
        const float mean = s * (1.0f / 512.0f), var = s2 * (1.0f / 512.0f) - mean * mean, rstd = rsqrtf(var + EPS);
        bf16_t* Vq = Vt + (size_t)(qd * 128) * VP + tk;
        if (qd >= glo && qd < ghi)
#pragma unroll
        for (int i = 0; i < 16; ++i) {
            const f32x4 ga = *(const f32x4*)(ng + 8 * i), gb = *(const f32x4*)(ng + 8 * i + 4); const float gg[8] = {ga[0], ga[1], ga[2], ga[3], gb[0], gb[1], gb[2], gb[3]};
#pragma unroll
            for (int e = 0; e < 4; ++e) { const unsigned w = gp[4 * i + e]; const float y0 = (bflo(w) - mean) * rstd * gg[2 * e], y1 = (bfhi(w) - mean) * rstd * gg[2 * e + 1];
                const unsigned p = pk2(y0, y1); const int c = 8 * i + 2 * e;
                Vq[(size_t)vperm(c) * VP] = (bf16_t)p; Vq[(size_t)vperm(c + 1) * VP] = (bf16_t)(p >> 16); } }
    }
    __syncthreads();
    const int T0 = row0 + 16 * wid;
    bf16x8 A[4][3];
    {
        const int i = 16 * wid + fr;
        const bf16_t* wsp = F.WSB() + ((size_t)(l * 4) * 128 + i) * 128 + 8 * fq;
        const bf16_t* up = F.PROJ16() + (size_t)(row0 + i) * 1536 + (GU_OFF - POOL_OFF) + 8 * fq;
        const float* bsp = F.gmlp_bs() + (size_t)(l * 4) * 128 + i;
        bf16x8 Aw[4]; u32x4 uw[4]; float bsv = bsp[128 * glo];
#pragma unroll
        for (int ks = 0; ks < 4; ++ks) Aw[ks] = *(const bf16x8*)(wsp + (size_t)glo * 128 * 128 + 32 * ks);
#pragma unroll
        for (int p = 0; p < 4; ++p) uw[p] = *(const u32x4*)(up + 128 * glo + 32 * p);
        for (int g = glo; g < ghi; ++g) {
            f32x4 acc[8];
#pragma unroll
            for (int nb = 0; nb < 8; ++nb) acc[nb] = (f32x4){0.f, 0.f, 0.f, 0.f};
            bf16x8 Awn[4]; u32x4 uwn[4]; float bsn = 0.f;
            if (g + 1 < ghi) {
#pragma unroll
                for (int ks = 0; ks < 4; ++ks) Awn[ks] = *(const bf16x8*)(wsp + (size_t)(g + 1) * 128 * 128 + 32 * ks);
#pragma unroll
                for (int p = 0; p < 4; ++p) uwn[p] = *(const u32x4*)(up + 128 * (g + 1) + 32 * p);
                bsn = bsp[128 * (g + 1)];
            } else {
#pragma unroll
                for (int bz = 0; bz < 3; ++bz) { int row = T0 - 16 + 16 * bz + fr; row = row < 0 ? 0 : (row > TV - 1 ? TV - 1 : row); const bf16_t* pa = F.PROJ16() + (size_t)row * 1536 + 128 * glo + 8 * fq;
#pragma unroll
                    for (int ks = 0; ks < 4; ++ks) A[ks][bz] = *(const bf16x8*)(pa + 32 * ks); }
#pragma unroll
                for (int ks = 0; ks < 4; ++ks) Awn[ks] = Aw[ks];
#pragma unroll
                for (int p = 0; p < 4; ++p) uwn[p] = uw[p];
            }
#pragma unroll
            for (int ks = 0; ks < 4; ++ks) {
#pragma unroll
                for (int nb = 0; nb < 8; ++nb) { const bf16x8 Bv = *(const bf16x8*)(Vt + (size_t)(128 * g + 16 * nb + fr) * VP + 32 * ks + 8 * fq);
                    acc[nb] = __builtin_amdgcn_mfma_f32_16x16x32_bf16(Bv, Aw[ks], acc[nb], 0, 0, 0); } }
            bf16_t* op = F.ACT() + (size_t)(row0 + i) * D + 1536 + 128 * g + 8 * fq;
#pragma unroll
            for (int p = 0; p < 4; ++p) { const unsigned ww[4] = {uw[p].x, uw[p].y, uw[p].z, uw[p].w}; unsigned o[4];
#pragma unroll
                for (int e = 0; e < 4; ++e) { const f32x4 av = acc[2 * p + (e >> 1)]; const int k = 2 * (e & 1);
                    o[e] = pk2(gelu_tanh(bflo(ww[e])) * (av[k] + bsv), gelu_tanh(bfhi(ww[e])) * (av[k + 1] + bsv)); }
                u32x4 w; w.x = o[0]; w.y = o[1]; w.z = o[2]; w.w = o[3]; *(u32x4*)(op + 32 * p) = w; }
#pragma unroll
            for (int ks = 0; ks < 4; ++ks) Aw[ks] = Awn[ks];
#pragma unroll
            for (int p = 0; p < 4; ++p) uw[p] = uwn[p];
            bsv = bsn;
        }
    }
    __syncthreads();
    {
        const bf16_t* src = F.PWT() + (size_t)(l * 4) * 128 * 128;
        u32x4 tmp[16];
#pragma unroll
        for (int i = 0; i < 16; ++i) { const int c = tid + 512 * i; if ((i >> 2) >= glo && (i >> 2) < ghi) tmp[i] = *(const u32x4*)(src + (size_t)(c >> 4) * 128 + (c & 15) * 8); else tmp[i] = (u32x4){0u, 0u, 0u, 0u}; }
#pragma unroll
        for (int i = 0; i < 16; ++i) { const int c = tid + 512 * i, row = c >> 4; if ((i >> 2) >= glo && (i >> 2) < ghi) *(u32x4*)(Vt + (size_t)((row & ~127) + vperm(row & 127)) * VP + (c & 15) * 8) = tmp[i]; }
    }
    __syncthreads();
    for (int g = glo; g < ghi; ++g) {
        const int win = 2 << g, back = win >> 1, fwd = win - 1 - back;
        bf16x8 An[4][3];
        if (g + 1 < ghi) {
#pragma unroll
            for (int bz = 0; bz < 3; ++bz) { int row = T0 - 16 + 16 * bz + fr; row = row < 0 ? 0 : (row > TV - 1 ? TV - 1 : row); const bf16_t* pa = F.PROJ16() + (size_t)row * 1536 + 128 * (g + 1) + 8 * fq;
#pragma unroll
                for (int ks = 0; ks < 4; ++ks) An[ks][bz] = *(const bf16x8*)(pa + 32 * ks); }
        } else {
#pragma unroll
            for (int ks = 0; ks < 4; ++ks)
#pragma unroll
                for (int bz = 0; bz < 3; ++bz) An[ks][bz] = A[ks][bz];
        }
        const int ti = T0 + fr, tloc = ti - slo; int lo = tloc - back; lo = lo < 0 ? 0 : lo; int hi = tloc + fwd; hi = hi > nseq - 1 ? nseq - 1 : hi;
        const float rc = 1.0f / (float)(hi - lo + 1);
        float cf[2][8];
#pragma unroll
        for (int s = 0; s < 2; ++s)
#pragma unroll
            for (int e = 0; e < 8; ++e) { const int bz = 2 * s + (e >> 2); const int tp = T0 - 16 + 16 * bz + 4 * fq + (e & 3); const int tl = tp - slo;
                float cv = (tl >= lo && tl <= hi) ? rc : 0.f; if (tp == ti) cv -= 1.0f; if (bz == 3) cv = 0.f; cf[s][e] = cv; }
        u32x4 a2w[2];
#pragma unroll
        for (int s = 0; s < 2; ++s) { a2w[s].x = pk2(cf[s][0], cf[s][1]); a2w[s].y = pk2(cf[s][2], cf[s][3]); a2w[s].z = pk2(cf[s][4], cf[s][5]); a2w[s].w = pk2(cf[s][6], cf[s][7]); }
        const bf16x8 A20 = __builtin_bit_cast(bf16x8, a2w[0]), A21 = __builtin_bit_cast(bf16x8, a2w[1]);
        const float* psc = F.pool_scale() + (size_t)l * 512 + 128 * g + 8 * fq;
        bf16_t* op = F.ACT() + (size_t)ti * D + 1024 + 128 * g + 8 * fq;
#pragma unroll
        for (int h = 0; h < 2; ++h) {
            f32x4 z[3][4];
#pragma unroll
            for (int bz = 0; bz < 3; ++bz)
#pragma unroll
                for (int q = 0; q < 4; ++q) z[bz][q] = (f32x4){0.f, 0.f, 0.f, 0.f};
            f32x4 scv[2][2];
#pragma unroll
            for (int pp = 0; pp < 2; ++pp) { scv[pp][0] = *(const f32x4*)(psc + 32 * (2 * h + pp)); scv[pp][1] = *(const f32x4*)(psc + 32 * (2 * h + pp) + 4); }
#pragma unroll
            for (int ks = 0; ks < 4; ++ks) {
#pragma unroll
                for (int q = 0; q < 4; ++q) { const bf16x8 B = *(const bf16x8*)(Vt + (size_t)(128 * g + 16 * (4 * h + q) + fr) * VP + 32 * ks + 8 * fq);
#pragma unroll
                    for (int bz = 0; bz < 3; ++bz) z[bz][q] = __builtin_amdgcn_mfma_f32_16x16x32_bf16(A[ks][bz], B, z[bz][q], 0, 0, 0); } }
#pragma unroll
            for (int pp = 0; pp < 2; ++pp) { f32x4 y[2];
#pragma unroll
                for (int o = 0; o < 2; ++o) { const int q = 2 * pp + o;
                    u32x4 b0, b1; b0.x = pk2(z[0][q][0], z[0][q][1]); b0.y = pk2(z[0][q][2], z[0][q][3]); b0.z = pk2(z[1][q][0], z[1][q][1]); b0.w = pk2(z[1][q][2], z[1][q][3]);
                    b1.x = pk2(z[2][q][0], z[2][q][1]); b1.y = pk2(z[2][q][2], z[2][q][3]); b1.z = 0u; b1.w = 0u;
                    y[o] = (f32x4){0.f, 0.f, 0.f, 0.f};
                    y[o] = __builtin_amdgcn_mfma_f32_16x16x32_bf16(__builtin_bit_cast(bf16x8, b0), A20, y[o], 0, 0, 0);
                    y[o] = __builtin_amdgcn_mfma_f32_16x16x32_bf16(__builtin_bit_cast(bf16x8, b1), A21, y[o], 0, 0, 0); }
                const f32x4 y0 = y[0] * scv[pp][0], y1 = y[1] * scv[pp][1];
                u32x4 w; w.x = pk2(y0[0], y0[1]); w.y = pk2(y0[2], y0[3]); w.z = pk2(y1[0], y1[1]); w.w = pk2(y1[2], y1[3]); *(u32x4*)(op + 32 * (2 * h + pp)) = w; }
        }
#pragma unroll
        for (int ks = 0; ks < 4; ++ks)
#pragma unroll
            for (int bz = 0; bz < 3; ++bz) A[ks][bz] = An[ks][bz];
    }
    __syncthreads();
}

DI void phase_qkprep(const Frame& F, int l, int wi, int nw) {
    if (wi < 0) return;
    constexpr int NRQ = 4;
    const int tid = opaque_tid(F.wv), wave = tid >> 6, lane = tid & 63, L7 = lane & 7;
    const int seg = L7 >> 2, isb = (L7 >> 1) & 1, ib = (L7 & 1) * 8;
    const f32x4 gq0 = *(const f32x4*)(F.q_norm_g() + l * 64 + L7 * 8) * QSCALE, gq1 = *(const f32x4*)(F.q_norm_g() + l * 64 + L7 * 8 + 4) * QSCALE;
    const f32x4 gk0 = *(const f32x4*)(F.k_norm_g() + l * 64 + L7 * 8), gk1 = *(const f32x4*)(F.k_norm_g() + l * 64 + L7 * 8 + 4);
    for (int r0 = wi * 8 + wave; r0 < TV; r0 += nw * 8 * NRQ) {
        u32x2 wq[NRQ][4]; f32x4 rc0[NRQ], rc1[NRQ], rs0[NRQ], rs1[NRQ];
#pragma unroll
        for (int q = 0; q < NRQ; ++q) { int r = r0 + q * nw * 8; r = r < TV ? r : TV - 1;
            const int b = r >= SEQV, j = r - b * SEQV; const int tl = j < CTX ? 0 : j - CTX, pos = seg ? (tl & 63) : (tl >> 6);
#pragma unroll
            for (int p = 0; p < 4; ++p) { const int grp = p * 8 + (lane >> 3);
                wq[q][p] = *(const u32x2*)(F.PROJ8() + (size_t)r * 3072 + (grp < 16 ? Q_OFF : K_OFF) + (grp & 15) * 64 + L7 * 8); }
            rc0[q] = *(const f32x4*)(F.ROPE() + pos * 16 + ib); rc1[q] = *(const f32x4*)(F.ROPE() + pos * 16 + ib + 4);
            rs0[q] = *(const f32x4*)(F.ROPE() + 4096 + pos * 16 + ib); rs1[q] = *(const f32x4*)(F.ROPE() + 4096 + pos * 16 + ib + 4); }
#pragma unroll
        for (int q = 0; q < NRQ; ++q) { const int r = r0 + q * nw * 8;
            if (r < TV) {
                const int b = r >= SEQV, j = r - b * SEQV; const bool isctx = j < CTX;
                float cs[8], sn[8];
#pragma unroll
                for (int e = 0; e < 4; ++e) { cs[e] = rc0[q][e]; cs[4 + e] = rc1[q][e]; sn[e] = rs0[q][e]; sn[4 + e] = rs1[q][e]; }
#pragma unroll
                for (int p = 0; p < 4; ++p) {
                    const int grp = p * 8 + (lane >> 3); const bool isq = grp < 16;
                    const u32x2 w = wq[q][p];
                    const int krow = j & 63;
                    char* kdst = F.KIMG() + ((size_t)((b * 16 + (grp & 15)) * NTILE + (j >> 6))) * 4096 + krow * 64 + ((((L7 >> 1) ^ ((krow >> 2) & 3)) << 4) | ((L7 & 1) << 3));
                    unsigned char* qdst = F.Q8() + ((size_t)r * 16 + (grp & 15)) * 64 + L7 * 8;
                    typedef float f2 __attribute__((ext_vector_type(2)));
                    const f2 x01 = __builtin_amdgcn_cvt_pk_f32_fp8(w.x, false), x23 = __builtin_amdgcn_cvt_pk_f32_fp8(w.x, true), x45 = __builtin_amdgcn_cvt_pk_f32_fp8(w.y, false), x67 = __builtin_amdgcn_cvt_pk_f32_fp8(w.y, true);
                    float x[8] = {x01[0], x01[1], x23[0], x23[1], x45[0], x45[1], x67[0], x67[1]};
                    float ss = 0.f;
#pragma unroll
                    for (int e = 0; e < 8; ++e) ss += x[e] * x[e];
                    ss += __shfl_xor(ss, 1); ss += __shfl_xor(ss, 2); ss += __shfl_xor(ss, 4);
                    const float rs = rsqrtf(ss * (1.0f / 64.0f) + EPS);
                    const f32x4 g0 = (isq ? gq0 : gk0) * rs, g1 = (isq ? gq1 : gk1) * rs;
                    float y[8];
#pragma unroll
                    for (int e = 0; e < 4; ++e) { y[e] = x[e] * g0[e]; y[4 + e] = x[4 + e] * g1[e]; }
                    if (!isctx) {
#pragma unroll
                        for (int e = 0; e < 8; ++e) { const float pr = __shfl_xor(y[e], 2); y[e] = isb ? (y[e] * cs[e] + pr * sn[e]) : (y[e] * cs[e] - pr * sn[e]); }
                    }
                    int w0 = __builtin_amdgcn_cvt_pk_fp8_f32(y[0], y[1], 0, false); w0 = __builtin_amdgcn_cvt_pk_fp8_f32(y[2], y[3], w0, true);
                    int w1 = __builtin_amdgcn_cvt_pk_fp8_f32(y[4], y[5], 0, false); w1 = __builtin_amdgcn_cvt_pk_fp8_f32(y[6], y[7], w1, true);
                    u32x2 o; o.x = (unsigned)w0; o.y = (unsigned)w1;
                    if (isq) *(u32x2*)qdst = o; else *(u32x2*)kdst = o;
                }
            }
        }
    }
}

DI void phase_vprep(const Frame& F, int wi, int nw) {
    if (wi < 0) return;
    const int tid = opaque_tid(F.wv), half = tid >> 8, c0 = 4 * (tid & 255), h = c0 >> 7, n0 = c0 & 127;
    for (int u = wi * 2 + half; u < NB * NTILE; u += nw * 2) {
        const int b = u / NTILE, tile = u % NTILE;
        const unsigned char* src = F.PROJ8() + (size_t)(b * SEQV + tile * 64) * 3072 + V_OFF + c0;
        char* dst = F.VIMG() + ((size_t)((b * 8 + h) * NTILE + tile)) * 8192;
        unsigned W[64];
#pragma unroll
        for (int pp = 0; pp < 64; ++pp) { const int r = pp & 15, key = ((pp >> 4) & 1) * 32 + (r & 3) + 8 * (r >> 2) + 4 * (pp >> 5); W[pp] = *(const unsigned*)(src + (size_t)key * 3072); }
#pragma unroll
        for (int ch = 0; ch < 4; ++ch) {
            unsigned o[4][4];
#pragma unroll
            for (int q = 0; q < 4; ++q) { const unsigned w0 = W[16 * ch + 4 * q], w1 = W[16 * ch + 4 * q + 1], w2 = W[16 * ch + 4 * q + 2], w3 = W[16 * ch + 4 * q + 3];
                const unsigned x0 = __builtin_amdgcn_perm(w1, w0, 0x05010400u), x1 = __builtin_amdgcn_perm(w1, w0, 0x07030602u);
                const unsigned y0 = __builtin_amdgcn_perm(w3, w2, 0x05010400u), y1 = __builtin_amdgcn_perm(w3, w2, 0x07030602u);
                o[0][q] = __builtin_amdgcn_perm(y0, x0, 0x05040100u); o[1][q] = __builtin_amdgcn_perm(y0, x0, 0x07060302u);
                o[2][q] = __builtin_amdgcn_perm(y1, x1, 0x05040100u); o[3][q] = __builtin_amdgcn_perm(y1, x1, 0x07060302u); }
#pragma unroll
            for (int c = 0; c < 4; ++c) { const int n = n0 + c; const u32x4 v = {o[c][0], o[c][1], o[c][2], o[c][3]};
                *(u32x4*)(dst + n * 64 + ((ch ^ ((n >> 2) & 3)) << 4)) = v; }
        }
    }
}

#ifndef PHMASK
#define PHMASK 0xFFFF
#endif
#define PHON(k) (((PHMASK) >> (k)) & 1)
#ifndef REP_PRO
#define REP_PRO 1
#endif
#ifndef REP_WIN
#define REP_WIN 1
#endif
#ifndef REP_MIX
#define REP_MIX 1
#endif
#ifndef REP_MOE
#define REP_MOE 1
#endif
#ifndef REP_ROW
#define REP_ROW 1
#endif
#ifndef REP_WOUT
#define REP_WOUT 1
#endif
constexpr int NPH = 26;

__global__ void __launch_bounds__(512, 2) fwd(Args args) {
    extern __shared__ __attribute__((aligned(16))) unsigned char lds[];
    Frame F0{args, 0, (char*)lds, (int)gridDim.x, 0, __builtin_amdgcn_readfirstlane((int)(threadIdx.x >> 6))};
    { const int bx = blockIdx.x; F0.vcu = (F0.G % 8 == 0) ? (bx % 8) * (F0.G / 8) + bx / 8 : bx; }
    LAS unsigned char* ldsl = (LAS unsigned char*)lds;
    if (threadIdx.x < 16) ((LAS unsigned*)(ldsl + MISC_OFF))[threadIdx.x] = 0u;
    __syncthreads();
    const int lo = args.ph_lo, hi = args.ph_hi;
    XcdBarrier bar; bar.bar = F0.ctl(); bar.x = 0; bar.wv = F0.wv; bar.st = (volatile LAS unsigned*)(ldsl + MISC_OFF);
    if (hi - lo > 1) bar = xcd_barrier_post(F0.ctl(), (volatile LAS unsigned*)(ldsl + MISC_OFF), F0.wv);
#define IN(k) (lo <= (k) && (k) < hi)
#ifndef REP_BAR
#define REP_BAR 1
#endif
#define SEAM(k) do { if (IN((k) + 1)) { for (int _rb = 0; _rb < REP_BAR; ++_rb) xcd_barrier(bar); } } while (0)

    if (PHON(0) && IN(0)) { const Frame F = fresh(F0); for (int rep = 0; rep < REP_PRO; ++rep) phase_prologue(F); SEAM(0); }

#pragma unroll
    for (int l = 0; l < DEPTH; ++l) {
        const int pb = 1 + 12 * l;
        if (PHON(1) && IN(pb + 0)) { const Frame F = fresh(F0); if (l == 0) phase_norm1<0>(F); else phase_norm1<1>(F);
            SEAM(pb + 0); }
        if (PHON(2) && IN(pb + 1)) { const Frame F = fresh(F0);
            pg8::Gemm g{F.ACT(), (const bf16_t*)((const unsigned char*)F.WIN() + (size_t)l * INC * D), D, nullptr}; pg8::StaticOrder S; S.init(TV / 256, INC / 256, F.G, (int)blockIdx.x, 0);
            pg8::EpiProj E{F.PROJ8(), F.PROJ16(), 1.0f / 32.0f};
            for (int rep = 0; rep < REP_WIN; ++rep) pg8::gemm_phase<pg8::EpiProj, pg8::StaticOrder, false, true>(ldsl, g, S, E, F.wv);
            SEAM(pb + 1);
        }
        if (PHON(3) && IN(pb + 2)) { const Frame F = fresh(F0);
            for (int rep = 0; rep < REP_MIX; ++rep) {
                for (int k = F.vcu; k < 2 * (SEQ / 128); k += F.G) mixer_unit(F, l, k < SEQ / 128 ? 2 + k : 4 + k, 0, 4);
                if (l == 0) for (int q = F.vcu; q < 16; q += F.G) { const int cc = q >> 2; mixer_unit(F, l, (cc >> 1) * (SEQV / 128) + (cc & 1), q & 3, (q & 3) + 1); }
            }
            const int nx = (l == 0 && F.G > 32) ? 16 : 0, wi = F.vcu - nx, nw = F.G - nx;
            phase_qkprep(F, l, wi, nw);
            phase_vprep(F, wi, nw);
            SEAM(pb + 2);
        }
        if (PHON(4) && IN(pb + 3)) { const Frame F = fresh(F0);
            const int nu = l == 0 ? 1024 + 16 : 1024;
            const float lam = F.LAM()[l], oml = 1.0f - (l == 0 ? 0.2f : 0.8f - 0.6f * 0.7408182206817179f);
            float* sgl = (float*)(F.lds + att::SHM_ATTN);
            { const int t_ = opaque_tid(F.wv); __syncthreads(); if (t_ < 128) sgl[t_] = F.subln_g()[(size_t)l * 128 + t_] * oml; __syncthreads(); }
            u32x4* park = F.PARK() + ((size_t)blockIdx.x * 512 + opaque_tid(F.wv)) * 8;
#ifndef REP_ATT
#define REP_ATT 1
#endif
            for (int rep = 0; rep < REP_ATT; ++rep)
            for (int u = F.vcu; u < nu; u += F.G) {
                int b, h, qrow0, nt;
                if (u < 1024) { const int qb = u & 63, bh = u >> 6; b = bh >> 3; h = bh & 7; qrow0 = b * SEQV + CTX + qb * 256; nt = NTILE; }
                else { const int bh = u - 1024; b = bh >> 3; h = bh & 7; qrow0 = b * SEQV; nt = CTX / 64; }
                const unsigned char* Qb = F.Q8() + ((size_t)qrow0 * 16 + h * 2) * 64;
                const char* Kimg = F.KIMG() + (size_t)((b * 16 + h * 2) * NTILE) * 4096;
                const char* Vimg = F.VIMG() + (size_t)((b * 8 + h) * NTILE) * 8192;
                bf16_t* Yb = F.ACT() + (size_t)qrow0 * D + h * 128;
                att::attn_unit(Qb, Kimg, Vimg, Yb, park, lam, sgl, nt, F.lds, ldsl, F.wv);
            }
            if (IN(pb + 5)) xcd_barrier(bar);
        }
        if (PHON(6) && IN(pb + 5)) { const Frame F = fresh(F0);
            pg8::Gemm g{F.ACT(), F.WOUT() + (size_t)l * D * D, D, nullptr}; pg8::StaticOrder S; S.init(l == 0 ? TV / 256 : NB * SEQ / 256, D / 256, F.G, (int)blockIdx.x, l == 1);
            pg8::EpiWout E{F.XB(), F.MOD() + (size_t)l * 18 * D};
            for (int rep = 0; rep < (l == 0 ? REP_WOUT : 1); ++rep) pg8::gemm_phase<pg8::EpiWout, pg8::StaticOrder, false>(ldsl, g, S, E, F.wv);
            SEAM(pb + 5);
        }
        if (PHON(7) && IN(pb + 6)) { const Frame F = fresh(F0); phase_norm2r(F, l);
            if (IN(pb + 9)) xcd_barrier(bar); }
        if (PHON(10) && IN(pb + 9)) { const Frame F = fresh(F0); phase_slots(F, l); SEAM(pb + 9); }
        if (PHON(11) && IN(pb + 10)) { const Frame F = fresh(F0);
            const int nblk = __builtin_amdgcn_readfirstlane(F.BLKE()[NBLK_MAX]);
            pg8::Gemm g{(const bf16_t*)F.ACT8(), (const bf16_t*)((const unsigned char*)F.GU() + (size_t)l * NEXP * 1024 * D), D, F.BUFT()}; pg8::MoeOrder S{F.BLKE(), nblk * 4, F.G, F.vcu, 4};
            pg8::EpiGU E{(unsigned char*)F.HID(), 1.0f / 32.0f};
            for (int rep = 0; rep < REP_MOE; ++rep) pg8::gemm_phase<pg8::EpiGU, pg8::MoeOrder, true, true>(ldsl, g, S, E, F.wv);
            SEAM(pb + 10);
        }
        if (PHON(12) && IN(pb + 11)) { const Frame F = fresh(F0);
            const int nblk = __builtin_amdgcn_readfirstlane(F.BLKE()[NBLK_MAX]);
            pg8::Gemm g{F.HID(), (const bf16_t*)((const unsigned char*)F.WD() + (size_t)l * NEXP * D * FF), FF, nullptr}; pg8::MoeOrder S{F.BLKE(), nblk * 8, F.G, F.vcu, 8};
            pg8::EpiDown E{(unsigned char*)F.YBUF(), F.BUFW(), 1.0f / 16.0f};
            for (int rep = 0; rep < REP_MOE; ++rep) pg8::gemm_phase<pg8::EpiDown, pg8::MoeOrder, false, true>(ldsl, g, S, E, F.wv);
            SEAM(pb + 11);
        }
    }
    if (PHON(13) && IN(25)) { const Frame F = fresh(F0); phase_final(F); }
#undef IN
#undef SEAM
}

extern "C" void kernel_launch(void* const* d_in, const int* in_sizes, int n_in, void* d_out, int out_size, void* d_ws, size_t ws_size, hipStream_t stream) {
    static int grid = 0;
    if (grid == 0) {
        if (n_in != 29 || out_size != NB * SEQ * D || ws_size < WS_END) { fprintf(stderr, "kernel_launch: built for 29 inputs, out %d floats, >= %zu bytes of workspace; got n_in %d, out %d, ws %zu\n", NB * SEQ * D, (size_t)WS_END, n_in, out_size, ws_size); grid = -1; return; }
        int dev = 0, cus = 0, per_cu = 0;
        if (hipGetDevice(&dev) != hipSuccess || hipDeviceGetAttribute(&cus, hipDeviceAttributeMultiprocessorCount, dev) != hipSuccess) { fprintf(stderr, "kernel_launch: device query failed\n"); grid = -1; return; }
        if (hipFuncSetAttribute((const void*)fwd, hipFuncAttributeMaxDynamicSharedMemorySize, LDS_BYTES) != hipSuccess) { fprintf(stderr, "kernel_launch: hipFuncSetAttribute failed\n"); grid = -1; return; }
        if (hipOccupancyMaxActiveBlocksPerMultiprocessor(&per_cu, (const void*)fwd, 512, LDS_BYTES) != hipSuccess || per_cu < 1)
            fprintf(stderr, "kernel_launch: note: occupancy query reports %d workgroups per CU\n", per_cu);
        (void)hipGetLastError();
        grid = cus;
    }
    if (grid < 0) return;
    if (hipMemsetAsync((char*)d_ws + WS_CTL, 0, CTL_BYTES, stream) != hipSuccess) { fprintf(stderr, "kernel_launch: memset failed\n"); return; }
    Args a{};
    for (int i = 0; i < 29; ++i) a.in[i] = (const float*)d_in[i];
    a.out = (float*)d_out; a.ws = (unsigned char*)d_ws;
#if MK_MULTI
    for (int p = 0; p < NPH; ++p) { a.ph_lo = p; a.ph_hi = p + 1; hipLaunchKernelGGL(fwd, dim3(grid), dim3(512), LDS_BYTES, stream, a); }
#else
    a.ph_lo = 0; a.ph_hi = NPH;
    hipLaunchKernelGGL(fwd, dim3(grid), dim3(512), LDS_BYTES, stream, a);
#endif
    const hipError_t le = hipPeekAtLastError();
    if (le != hipSuccess) fprintf(stderr, "kernel_launch: launch failed: %s\n", hipGetErrorName(le));
}
```

```cpp
#include <hip/hip_runtime.h>
#include <cstdio>
#include <cstdint>

#ifndef MK_MULTI
#define MK_MULTI 0
#endif

constexpr int D = 2048, NB = 2, SEQ = 16384, CTX = 256, DEPTH = 2;
constexpr int SEQV = SEQ + CTX;
constexpr int TV = NB * SEQV;
constexpr int INC = 4608;
constexpr int NH = 8;
constexpr int Q_OFF = 0, K_OFF = 1024, V_OFF = 2048, POOL_OFF = 3072, GU_OFF = 3584, GV_OFF = 4096;
constexpr int NEXP = 32, FF = 512;
constexpr int NSLOT_MAX = 74752;
constexpr int NBLK_MAX = NSLOT_MAX / 256;
constexpr float EPS = 1e-6f;
constexpr float QSCALE = 0.125f * 1.4426950408889634f;

typedef unsigned short bf16_t;
typedef short bf16x8 __attribute__((ext_vector_type(8)));
typedef short s16x4 __attribute__((ext_vector_type(4)));
typedef float f32x2 __attribute__((ext_vector_type(2)));
typedef float f32x4 __attribute__((ext_vector_type(4)));
typedef float f32x16 __attribute__((ext_vector_type(16)));
typedef unsigned u32x2 __attribute__((ext_vector_type(2)));
typedef unsigned u32x4 __attribute__((ext_vector_type(4)));
typedef __bf16 bfv2 __attribute__((ext_vector_type(2)));
#define LAS __attribute__((address_space(3)))
#define DI __device__ __forceinline__
#define GAS __attribute__((address_space(1)))

DI unsigned pk2(float a, float b) { f32x2 v = {a, b}; bfv2 r = __builtin_convertvector(v, bfv2); return __builtin_bit_cast(unsigned, r); }
DI float bflo(unsigned w) { return __uint_as_float(w << 16); }
DI float bfhi(unsigned w) { return __uint_as_float(w & 0xffff0000u); }
DI float bf1(bf16_t h) { return __uint_as_float(((unsigned)h) << 16); }
DI int lane_id() { return (int)__builtin_amdgcn_mbcnt_hi(~0u, __builtin_amdgcn_mbcnt_lo(~0u, 0u)); }
DI int opaque_tid(int wv) { int w = wv, l = lane_id(); asm volatile("" : "+s"(w), "+v"(l)); return (w << 6) | l; }
DI float wave_sum(float v) {
#pragma unroll
    for (int o = 32; o >= 1; o >>= 1) v += __shfl_xor(v, o);
    return v;
}
DI float gelu_tanh(float x) {
    const float u = x * (-2.3022081981f - 0.10294323958f * x * x);
    return x * __builtin_amdgcn_rcpf(1.0f + __builtin_amdgcn_exp2f(u));
}
DI float silu_f(float x) { return x * __builtin_amdgcn_rcpf(1.0f + __expf(-x)); }

constexpr size_t al256(size_t x) { return (x + 255) / 256 * 256; }
constexpr size_t WS_CTL   = 0;
constexpr size_t CTL_BYTES = 65536;
constexpr size_t CW_CNT   = 16384;
constexpr size_t WS_MOD   = WS_CTL + CTL_BYTES;
constexpr size_t WS_LAM   = WS_MOD + al256((size_t)2 * 3 * 6 * D * 4);
constexpr size_t WS_ROPE  = WS_LAM + 256;
constexpr size_t WS_WSB   = WS_ROPE + 2 * 256 * 16 * 4;
constexpr size_t WS_PWT   = WS_WSB + (size_t)2 * 4 * 128 * 128 * 2;
constexpr size_t WS_RWT   = WS_PWT + (size_t)2 * 4 * 128 * 128 * 2;
constexpr size_t WS_WIN   = WS_RWT + (size_t)2 * 256 * D * 2;
constexpr size_t WS_WOUT  = WS_WIN + (size_t)2 * INC * D;
constexpr size_t WS_GU    = WS_WOUT + (size_t)2 * D * D * 2;
constexpr size_t WS_WD    = WS_GU + (size_t)2 * NEXP * 1024 * D;
constexpr size_t WS_ACT   = WS_WD + (size_t)2 * NEXP * D * FF;
constexpr size_t WS_PROJ  = WS_ACT + (size_t)TV * D * 2;
constexpr size_t PROJ_BYTES = (size_t)TV * INC * 2;
static_assert((size_t)NSLOT_MAX * D * 2 <= PROJ_BYTES, "YBUF must fit in PROJ");
constexpr size_t WS_OPART = WS_PROJ + al256(PROJ_BYTES);
constexpr size_t OPART_BYTES = (size_t)160 << 20;
constexpr size_t OFF_LOGITS = 0, OFF_HID = al256((size_t)TV * 64 * 4);
constexpr size_t OFF_ACT8 = OFF_HID + al256((size_t)NSLOT_MAX * FF * 2);
static_assert(OFF_ACT8 + (size_t)TV * D <= OPART_BYTES, "HID + ACT8 must fit in OPART");
constexpr size_t WS_XB    = WS_OPART + al256(OPART_BYTES);
constexpr size_t WS_ASGE  = WS_XB + (size_t)TV * D * 2;
constexpr size_t WS_ASGP  = WS_ASGE + al256((size_t)TV * 2 * 4);
constexpr size_t WS_ASGW  = WS_ASGP + al256((size_t)TV * 2 * 4);
constexpr size_t WS_SLOT  = WS_ASGW + al256((size_t)TV * 2 * 4);
constexpr size_t WS_BUFT  = WS_SLOT + al256((size_t)TV * 2 * 4);
constexpr size_t WS_BUFW  = WS_BUFT + al256((size_t)NSLOT_MAX * 4);
constexpr size_t WS_BLKE  = WS_BUFW + al256((size_t)NSLOT_MAX * 4);
constexpr size_t WS_KIMG  = WS_BLKE + al256((size_t)(NBLK_MAX + 4) * 4);
constexpr int NTILE = SEQV / 64;
constexpr size_t WS_VIMG  = WS_KIMG + (size_t)NB * 16 * NTILE * 4096;
constexpr size_t WS_Q8    = WS_VIMG + (size_t)NB * 8 * NTILE * 8192;
constexpr size_t WS_PARK  = WS_Q8 + (size_t)TV * 1024;
constexpr size_t WS_END   = WS_PARK + (size_t)512 * 512 * 128;

constexpr int LDS_BYTES = 147456;
constexpr int MISC_OFF = LDS_BYTES - 64;

#define XB_TMO      128
#define XB_XCNT(j)  (256  + 64 * (j))
#define XB_XSUB(j)  (1280 + 64 * (j))
#define XB_XGEN(j)  (2304 + 64 * (j))
#define XB_TOP      3328
#define XB_TOPGEN   3392
#define XCD_BAR_WORDS 3456
#define XB_SPIN_CAP (1u << 21)

__device__ __forceinline__ unsigned xb_ld(unsigned* p)              { return __hip_atomic_load(p, __ATOMIC_RELAXED, __HIP_MEMORY_SCOPE_AGENT); }
__device__ __forceinline__ unsigned xb_add(unsigned* p, unsigned v) { return __hip_atomic_fetch_add(p, v, __ATOMIC_RELAXED, __HIP_MEMORY_SCOPE_AGENT); }
__device__ __forceinline__ unsigned xb_xcc_id() { return (unsigned)__builtin_amdgcn_s_getreg((3 << 11) | 20) & 0xFu; }
#define XB_SPIN(cond, bar) do { unsigned _sp = 0; while (cond) { __builtin_amdgcn_s_sleep(1); \
    if ((++_sp & 255u) == 0u) { if (xb_ld(&(bar)[XB_TMO])) break; if (_sp > XB_SPIN_CAP) { atomicAdd(&(bar)[XB_TMO], 1u); break; } } } } while (0)

struct XcdBarrier {
    unsigned* bar; unsigned x; int wv;
    volatile LAS unsigned* st;
};

__device__ __forceinline__ XcdBarrier xcd_barrier_post(unsigned* bar, volatile LAS unsigned* st, int wv) {
    XcdBarrier b; b.bar = bar; b.x = xb_xcc_id(); b.st = st; b.wv = wv;
    if (wv == 0 && lane_id() == 0) (void)xb_add(&bar[XB_XCNT(b.x)], 1u);
    return b;
}
__device__ __forceinline__ void xcd_barrier_complete(unsigned* bar, unsigned x, unsigned& nloc, unsigned& nx) {
    const unsigned G = gridDim.x * gridDim.y * gridDim.z;
    unsigned sum, cnt, mine, sp = 0u;
    for (;;) {
        sum = 0u; cnt = 0u; mine = 0u;
#pragma unroll
        for (unsigned j = 0; j < 16; ++j) { const unsigned c = xb_ld(&bar[XB_XCNT(j)]); sum += c; cnt += (c > 0u) ? 1u : 0u; mine = (j == x) ? c : mine; }
        if (sum == G) break;
        __builtin_amdgcn_s_sleep(1);
        if ((++sp & 255u) == 0u) { if (xb_ld(&bar[XB_TMO])) break; if (sp > XB_SPIN_CAP) { atomicAdd(&bar[XB_TMO], 1u); break; } }
    }
    nloc = mine > 0u ? mine : 1u; nx = cnt > 0u ? cnt : 1u;
}

__device__ __forceinline__ void xcd_barrier(const XcdBarrier& b) {
    asm volatile("s_waitcnt vmcnt(0)" ::: "memory");
    __syncthreads();
    if (b.wv == 0 && lane_id() == 0) {
        unsigned* bar = b.bar;
        __builtin_amdgcn_s_waitcnt(0);
        unsigned nloc = b.st[0], nx = b.st[1];
        if (nloc == 0u) { xcd_barrier_complete(bar, b.x, nloc, nx); b.st[0] = nloc; b.st[1] = nx; }
        const unsigned old = xb_add(&bar[XB_XSUB(b.x)], 1u);
        const unsigned gen = old / nloc;
        if (old + 1u == (gen + 1u) * nloc) {
            __builtin_amdgcn_fence(__ATOMIC_RELEASE, "agent");
            asm volatile("s_waitcnt vmcnt(0)" ::: "memory");
            const unsigned og = xb_add(&bar[XB_TOP], 1u);
            const unsigned tg = og / nx;
            if (og + 1u == (tg + 1u) * nx) xb_add(&bar[XB_TOPGEN], 1u);
            else XB_SPIN(xb_ld(&bar[XB_TOPGEN]) == tg, bar);
            __builtin_amdgcn_fence(__ATOMIC_ACQUIRE, "agent");
            xb_add(&bar[XB_XGEN(b.x)], 1u);
            asm volatile("s_waitcnt vmcnt(0)" ::: "memory");
        } else {
            XB_SPIN(xb_ld(&bar[XB_XGEN(b.x)]) == gen, bar);
            __builtin_amdgcn_fence(__ATOMIC_ACQUIRE, "agent");
            asm volatile("s_waitcnt vmcnt(0)" ::: "memory");
        }
    }
    __syncthreads();
}

namespace pg8 {
constexpr int BM = 256, BK = 64, HALF = 128, HTB = HALF * BK * 2  , STAGE_BYTES = 8 * HTB, NXCD = 8, WGM = 8;

__host__ __device__ __forceinline__ int lds_byte(int r, int c) { const int st = (r >> 4) * 2 + (c >> 5), rr = r & 15, cc = c & 31, ob = rr * 64 + cc * 2; return st * 1024 + (ob ^ (((ob >> 9) & 1) << 5)); }
__host__ __device__ __forceinline__ void stage_rc(int b, int& R, int& C) { const int st = b / 1024, sb = b % 1024, swz = sb ^ (((sb >> 9) & 1) << 5); R = (st >> 1) * 16 + swz / 64; C = (st & 1) * 32 + (swz % 64) / 2; }
__host__ __device__ __forceinline__ int perm32(int rho) { const int n = rho >> 4, i = rho & 15; return 8 * (i >> 2) + 4 * n + (i & 3); }

struct Unit { int pm, pn; };
struct Gemm { const bf16_t* A; const bf16_t* Bt; int K; const int* gath; };

struct StaticOrder {
    int nM, nN, nwg, G, c, skipctx;
    __device__ void init(int nM_, int nN_, int G_, int c_, int skipctx_) { nM = nM_; nN = nN_; nwg = nM * nN; G = G_; c = c_; skipctx = skipctx_; }
    __device__ bool next(int i, Unit& u) const {
        const long L = (long)i * G + c; if (L >= nwg) return false;
        int wgid = (int)L; { const int q = nwg / NXCD, r = nwg % NXCD, xcd = wgid % NXCD, off = wgid / NXCD; wgid = (xcd < r ? xcd * (q + 1) : r * (q + 1) + (xcd - r) * q) + off; }
        const int nig = WGM * nN, gid = wgid / nig, fm = gid * WGM, gsz = (nM - fm) < WGM ? (nM - fm) : WGM;
        int pm = fm + ((wgid % nig) % gsz); u.pn = (wgid % nig) / gsz;
        if (skipctx) pm = pm + 1 + (pm >= 64);
        u.pm = pm; return true;
    }
};
struct MoeOrder {
    const LAS int* blk_e; int n_units, G, c, NT;
    __device__ bool next(int i, Unit& u) const {
        const long L = (long)i * G + c; if (L >= n_units) return false;
        const int blk = (int)L / NT, j = (int)L % NT; u.pm = blk; u.pn = __builtin_amdgcn_readfirstlane(blk_e[blk]) * NT + j; return true;
    }
};

typedef int i32x8 __attribute__((ext_vector_type(8)));
typedef int u32x4_i __attribute__((ext_vector_type(4)));
template <class Epi, class Sched, bool GATHER, bool FP8 = false>
__device__ __forceinline__ void gemm_phase(LAS unsigned char* lds, const Gemm g, const Sched& S, const Epi& E, int wv) {
    const int tid = opaque_tid(wv), wid = __builtin_amdgcn_readfirstlane(tid >> 6), lane = tid & 63, wr = wid >> 2, wc = wid & 3, fr = lane & 15, fq = lane >> 4;
    constexpr int ES = FP8 ? 1 : 2;
    const int K = g.K, KB = K * ES, nt = KB / 128;
    unsigned voffB[2][2]; unsigned vA[2][2], vAn[2][2];
    const size_t kstep = (size_t)(BK * 2);
    const size_t hstep = (size_t)HALF * KB;
    const size_t tstep = 2 * hstep;
#pragma unroll
    for (int i = 0; i < 2; ++i) { int R, C; stage_rc(tid * 16 + i * 8192, R, C);
#pragma unroll
        for (int h = 0; h < 2; ++h) { const int Rb = Epi::PERM == 2 ? 64 * (R >> 5) + 16 * ((R & 15) >> 2) + 8 * h + 4 * ((R >> 4) & 1) + (R & 3)
                                                     : HALF * h + (Epi::PERM == 1 ? ((R & ~31) + perm32(R & 31)) : R);
            voffB[h][i] = (unsigned)(Rb * KB + C * 2); }
        vA[0][i] = (unsigned)(R * KB + C * 2); vA[1][i] = vA[0][i] + (unsigned)hstep; vAn[0][i] = vA[0][i]; vAn[1][i] = vA[1][i]; }
    const unsigned ldsw = (unsigned)wid * 1024u, lds32 = (unsigned)(size_t)lds;
    const int aoff = lds_byte(wr * 64 + fr, fq * 8); int boff = lds_byte(wc * 32 + fr, fq * 8) + 4 * HTB;
    asm volatile("" : "+v"(boff));
#define PG8_SA(b, h) (((b) * 2 + (h)) * HTB)
#define PG8_SB(b, h) ((4 + (b) * 2 + (h)) * HTB)
#define PG8_SBR(b, h) (((b) * 2 + (h)) * HTB)
#define PG8_STAGE(bufoff, gbase, voff) do { _Pragma("unroll") for (int _i = 0; _i < 2; ++_i) \
        asm volatile("s_nop 0\n\tglobal_load_lds_dwordx4 %0, %1" :: "v"((voff)[_i]), "s"((const char*)(gbase)), "{m0}"(lds32 + (unsigned)(bufoff) + ldsw + (unsigned)(_i * 8192)) : "memory"); } while (0)
#define PG8_LD16(off) (*(const LAS u32x4_i*)(lds + (off)))
#define PG8_LDA(dst, b, h) do { _Pragma("unroll") for (int m = 0; m < 4; ++m) { if constexpr (FP8) { const u32x4_i _x = PG8_LD16(PG8_SA(b, h) + aoff + m * 2048), _y = PG8_LD16(PG8_SA(b, h) + aoff + m * 2048 + 1024); \
            dst##8[m] = __builtin_shufflevector(_x, _y, 0, 1, 2, 3, 4, 5, 6, 7); } \
        else { _Pragma("unroll") for (int k = 0; k < 2; ++k) dst[m][k] = *(const LAS bf16x8*)(lds + PG8_SA(b, h) + aoff + m * 2048 + k * 1024); } } } while (0)
#define PG8_LDB(dst, b, h) do { _Pragma("unroll") for (int n = 0; n < 2; ++n) { if constexpr (FP8) { const u32x4_i _x = PG8_LD16(PG8_SBR(b, h) + boff + n * 2048), _y = PG8_LD16(PG8_SBR(b, h) + boff + n * 2048 + 1024); \
            dst##8[n] = __builtin_shufflevector(_x, _y, 0, 1, 2, 3, 4, 5, 6, 7); } \
        else { _Pragma("unroll") for (int k = 0; k < 2; ++k) dst[n][k] = *(const LAS bf16x8*)(lds + PG8_SBR(b, h) + boff + n * 2048 + k * 1024); } } } while (0)
#define PG8_MMA(ai, bj, At, Bt) do { __builtin_amdgcn_s_setprio(1); _Pragma("unroll") for (int m = 0; m < 4; ++m) _Pragma("unroll") for (int n = 0; n < 2; ++n) { \
        if constexpr (FP8) asm volatile("v_mfma_f32_16x16x128_f8f6f4 %0, %1, %2, %0" : "+v"(acc[ai][bj][m][n]) : "v"(Bt##8[n]), "v"(At##8[m])); \
        else { _Pragma("unroll") for (int k = 0; k < 2; ++k) acc[ai][bj][m][n] = __builtin_amdgcn_mfma_f32_16x16x32_bf16(Bt[n][k], At[m][k], acc[ai][bj][m][n], 0, 0, 0); } } \
        __builtin_amdgcn_s_setprio(0); } while (0)
#define PG8_WAIT_V(n) asm volatile("s_waitcnt vmcnt(" #n ")" ::: "memory")
#define PG8_WAIT_L(n) asm volatile("s_waitcnt lgkmcnt(" #n ")" ::: "memory")
#define PG8_BAR __builtin_amdgcn_s_barrier()
#define PG8_SCHED __builtin_amdgcn_sched_barrier(0)
#define PG8_GATH(dst, pm_) do { _Pragma("unroll") for (int _i = 0; _i < 2; ++_i) { int _R, _C; stage_rc(opaque_tid(wv) * 16 + _i * 8192, _R, _C); \
        _Pragma("unroll") for (int _h = 0; _h < 2; ++_h) { int _t = g.gath[(pm_) * BM + _h * HALF + _R]; _t = _t < 0 ? 0 : _t; dst[_h][_i] = (unsigned)(_t * KB + _C * 2); } } } while (0)
    Unit cur, nxt; int ui = 0;
    if (!S.next(0, cur)) return;
    f32x4 acc[2][2][4][2];
#pragma unroll
    for (int a = 0; a < 2; ++a)
#pragma unroll
        for (int b = 0; b < 2; ++b)
#pragma unroll
            for (int m = 0; m < 4; ++m)
#pragma unroll
                for (int n = 0; n < 2; ++n) acc[a][b][m][n] = (f32x4){0.f, 0.f, 0.f, 0.f};
    bf16x8 At[4][2], B0[2][2], B1[2][2]; i32x8 At8[4], B08[2], B18[2];
    const char* cA = GATHER ? (const char*)g.A : (const char*)g.A + (size_t)cur.pm * tstep; const char* cB = (const char*)g.Bt + (size_t)cur.pn * tstep;
    if (GATHER) { PG8_GATH(vA, cur.pm); }
    PG8_STAGE(PG8_SB(0, 0), cB, voffB[0]); PG8_STAGE(PG8_SA(0, 0), cA, vA[0]); PG8_STAGE(PG8_SB(0, 1), cB, voffB[1]); PG8_STAGE(PG8_SA(0, 1), cA, vA[1]);
    if (wr == 1) PG8_BAR;
    PG8_WAIT_V(4); PG8_BAR;
    PG8_STAGE(PG8_SB(1, 0), cB + kstep, voffB[0]); PG8_STAGE(PG8_SA(1, 0), cA + kstep, vA[0]); PG8_STAGE(PG8_SB(1, 1), cB + kstep, voffB[1]);
    PG8_WAIT_V(6); PG8_BAR;
    for (;;) {
        const bool has_next = S.next(ui + 1, nxt);
        float pw[8];
        if constexpr (Epi::NPREF != 0) E.prefetch(pw, cur, wr, fr);
        const char* nA = GATHER ? cA : (has_next ? (const char*)g.A + (size_t)nxt.pm * tstep : cA); const char* nB = has_next ? (const char*)g.Bt + (size_t)nxt.pn * tstep : cB;
        if (GATHER) { if (has_next) { PG8_GATH(vAn, nxt.pm); } else {
#pragma unroll
            for (int h = 0; h < 2; ++h)
#pragma unroll
                for (int i = 0; i < 2; ++i) vAn[h][i] = vA[h][i]; } }
        for (int t = 0; t < nt; t += 2) {
            const bool last = (t == nt - 2);
            const char* a1 = cA + (size_t)(t + 1) * kstep;
            const char* a2 = last ? nA : cA + (size_t)(t + 2) * kstep; const char* b2 = last ? nB : cB + (size_t)(t + 2) * kstep;
            const char* a3 = a2 + kstep; const char* b3 = b2 + kstep;
            unsigned w0[2], w1[2];
#pragma unroll
            for (int i = 0; i < 2; ++i) { w0[i] = (GATHER && last) ? vAn[0][i] : vA[0][i]; w1[i] = (GATHER && last) ? vAn[1][i] : vA[1][i]; }
            PG8_LDB(B0, 0, 0); PG8_SCHED; PG8_LDA(At, 0, 0); PG8_STAGE(PG8_SA(1, 1), a1, vA[1]);
            PG8_WAIT_L(8); PG8_BAR; PG8_WAIT_L(0); PG8_MMA(0, 0, At, B0); PG8_BAR; PG8_SCHED;
            PG8_LDB(B1, 0, 1); PG8_STAGE(PG8_SB(0, 0), b2, voffB[0]);
            PG8_BAR; PG8_WAIT_L(0); PG8_MMA(0, 1, At, B1); PG8_BAR;
            PG8_LDA(At, 0, 1); PG8_STAGE(PG8_SA(0, 0), a2, w0);
            PG8_BAR; PG8_WAIT_L(0); PG8_MMA(1, 0, At, B0); PG8_BAR; PG8_SCHED;
            PG8_STAGE(PG8_SB(0, 1), b2, voffB[1]);
            PG8_WAIT_V(6); PG8_BAR; PG8_MMA(1, 1, At, B1); PG8_BAR;
            PG8_LDB(B0, 1, 0); PG8_SCHED; PG8_LDA(At, 1, 0); PG8_STAGE(PG8_SA(0, 1), a2, w1);
            PG8_WAIT_L(8); PG8_BAR; PG8_WAIT_L(0); PG8_MMA(0, 0, At, B0); PG8_BAR; PG8_SCHED;
            PG8_LDB(B1, 1, 1); PG8_STAGE(PG8_SB(1, 0), b3, voffB[0]);
            PG8_BAR; PG8_WAIT_L(0); PG8_MMA(0, 1, At, B1); PG8_BAR;
            PG8_LDA(At, 1, 1); PG8_STAGE(PG8_SA(1, 0), a3, w0);
            PG8_BAR; PG8_WAIT_L(0); PG8_MMA(1, 0, At, B0); PG8_BAR; PG8_SCHED;
            PG8_STAGE(PG8_SB(1, 1), b3, voffB[1]);
            PG8_WAIT_V(6); PG8_BAR; PG8_MMA(1, 1, At, B1); PG8_BAR;
        }
        if constexpr (FP8) asm volatile("s_nop 15\n\ts_nop 15\n\ts_nop 7" ::: "memory");
        E(acc, cur, wr, wc, fr, fq, pw);
        if (!has_next) break;
#pragma unroll
        for (int a = 0; a < 2; ++a)
#pragma unroll
            for (int b = 0; b < 2; ++b)
#pragma unroll
                for (int m = 0; m < 4; ++m)
#pragma unroll
                    for (int n = 0; n < 2; ++n) acc[a][b][m][n] = (f32x4){0.f, 0.f, 0.f, 0.f};
        cur = nxt; cA = nA; cB = nB; ++ui;
#pragma unroll
        for (int h = 0; h < 2; ++h)
#pragma unroll
            for (int i = 0; i < 2; ++i) vA[h][i] = vAn[h][i];
    }
    PG8_WAIT_V(0);
    if (wr == 0) PG8_BAR;
    PG8_BAR;
#undef PG8_SA
#undef PG8_SB
#undef PG8_SBR
#undef PG8_STAGE
#undef PG8_LDA
#undef PG8_LD16
#undef PG8_LDB
#undef PG8_MMA
#undef PG8_WAIT_V
#undef PG8_WAIT_L
#undef PG8_BAR
#undef PG8_SCHED
#undef PG8_GATH
}

struct EpiProj {
    static constexpr int PERM = 2, NPREF = 0;
    unsigned char* P8; bf16_t* P16; float sc;
    __device__ __forceinline__ void operator()(const f32x4 (&acc)[2][2][4][2], const Unit& u, int wr, int wc, int fr, int fq, const float (&pw)[8]) const {
        const int row0 = u.pm * BM + wr * 64 + fr;
        if (u.pn < 12) {
            const int col0 = u.pn * BM + wc * 64 + 16 * fq;
#pragma unroll
            for (int ai = 0; ai < 2; ++ai)
#pragma unroll
                for (int m = 0; m < 4; ++m) { unsigned char* rowp = P8 + (size_t)(row0 + ai * HALF + m * 16) * 3072 + col0; int w[4];
#pragma unroll
                    for (int bj = 0; bj < 2; ++bj)
#pragma unroll
                        for (int n = 0; n < 2; ++n) { const f32x4 v = acc[ai][bj][m][n] * sc;
                            int x = __builtin_amdgcn_cvt_pk_fp8_f32(v[0], v[1], 0, false); x = __builtin_amdgcn_cvt_pk_fp8_f32(v[2], v[3], x, true); w[bj * 2 + n] = x; }
                    u32x4 o; o.x = (unsigned)w[0]; o.y = (unsigned)w[1]; o.z = (unsigned)w[2]; o.w = (unsigned)w[3]; *(u32x4*)rowp = o; }
        } else {
            const int col0 = (u.pn - 12) * BM + wc * 64 + 16 * fq;
#pragma unroll
            for (int ai = 0; ai < 2; ++ai)
#pragma unroll
                for (int m = 0; m < 4; ++m) { bf16_t* rowp = P16 + (size_t)(row0 + ai * HALF + m * 16) * 1536 + col0;
#pragma unroll
                    for (int bj = 0; bj < 2; ++bj) { const f32x4 v0 = acc[ai][bj][m][0] * sc, v1 = acc[ai][bj][m][1] * sc;
                        u32x4 w; w.x = pk2(v0[0], v0[1]); w.y = pk2(v0[2], v0[3]); w.z = pk2(v1[0], v1[1]); w.w = pk2(v1[2], v1[3]);
                        *(u32x4*)(rowp + bj * 8) = w; } }
        }
    }
};
struct EpiWout {
    static constexpr int PERM = 1, NPREF = 0;
    bf16_t* X; const float* mod_l;
    __device__ __forceinline__ void operator()(const f32x4 (&acc)[2][2][4][2], const Unit& u, int wr, int wc, int fr, int fq, const float (&pw)[8]) const {
        const int b = u.pm >= 65, jt = u.pm - 65 * b; const bool isctx = (jt == 0);
        const float* g1 = mod_l + (size_t)(isctx ? 2 : b) * 6 * D + 2 * D;
        const int row0 = u.pm * BM + wr * 64 + fr, col0 = u.pn * BM + wc * 32 + 8 * fq;
        f32x4 gv[2][2];
#pragma unroll
        for (int bj = 0; bj < 2; ++bj)
#pragma unroll
            for (int n = 0; n < 2; ++n) gv[bj][n] = *(const f32x4*)(g1 + col0 + bj * HALF + n * 4);
#pragma unroll
        for (int ai = 0; ai < 2; ++ai)
#pragma unroll
            for (int m = 0; m < 4; ++m) { bf16_t* rp = X + (size_t)(row0 + ai * HALF + m * 16) * D + col0;
#pragma unroll
                for (int bj = 0; bj < 2; ++bj) { const u32x4 xw = *(const u32x4*)(rp + bj * HALF);
                    const f32x4 x0 = (f32x4){bflo(xw.x), bfhi(xw.x), bflo(xw.y), bfhi(xw.y)} + gv[bj][0] * acc[ai][bj][m][0];
                    const f32x4 x1 = (f32x4){bflo(xw.z), bfhi(xw.z), bflo(xw.w), bfhi(xw.w)} + gv[bj][1] * acc[ai][bj][m][1];
                    u32x4 w; w.x = pk2(x0[0], x0[1]); w.y = pk2(x0[2], x0[3]); w.z = pk2(x1[0], x1[1]); w.w = pk2(x1[2], x1[3]); *(u32x4*)(rp + bj * HALF) = w; } }
    }
};
struct EpiGU {
    static constexpr int PERM = 1, NPREF = 0;
    unsigned char* H; float sc;
    __device__ __forceinline__ void operator()(const f32x4 (&acc)[2][2][4][2], const Unit& u, int wr, int wc, int fr, int fq, const float (&pw)[8]) const {
        const int row0 = u.pm * BM + wr * 64 + fr, col0 = (u.pn & 3) * 128 + wc * 32 + 8 * fq;
#pragma unroll
        for (int ai = 0; ai < 2; ++ai)
#pragma unroll
            for (int m = 0; m < 4; ++m) { unsigned char* rowp = H + (size_t)(row0 + ai * HALF + m * 16) * FF + col0;
                float h[8];
#pragma unroll
                for (int n = 0; n < 2; ++n)
#pragma unroll
                    for (int j = 0; j < 4; ++j) h[n * 4 + j] = silu_f(acc[ai][0][m][n][j] * sc) * (acc[ai][1][m][n][j] * sc);
                int w0 = __builtin_amdgcn_cvt_pk_fp8_f32(h[0], h[1], 0, false); w0 = __builtin_amdgcn_cvt_pk_fp8_f32(h[2], h[3], w0, true);
                int w1 = __builtin_amdgcn_cvt_pk_fp8_f32(h[4], h[5], 0, false); w1 = __builtin_amdgcn_cvt_pk_fp8_f32(h[6], h[7], w1, true);
                u32x2 w; w.x = (unsigned)w0; w.y = (unsigned)w1; *(u32x2*)rowp = w; }
    }
};
struct EpiDown {
    static constexpr int PERM = 2, NPREF = 8;
    unsigned char* Y; const float* bufw; float sc;
    __device__ __forceinline__ void prefetch(float (&pw)[8], const Unit& u, int wr, int fr) const {
        const int row0 = u.pm * BM + wr * 64 + fr;
#pragma unroll
        for (int ai = 0; ai < 2; ++ai)
#pragma unroll
            for (int m = 0; m < 4; ++m) pw[ai * 4 + m] = bufw[row0 + ai * HALF + m * 16];
    }
    __device__ __forceinline__ void operator()(const f32x4 (&acc)[2][2][4][2], const Unit& u, int wr, int wc, int fr, int fq, const float (&pw)[8]) const {
        const int row0 = u.pm * BM + wr * 64 + fr, col0 = (u.pn & 7) * BM + wc * 64 + 16 * fq;
#pragma unroll
        for (int ai = 0; ai < 2; ++ai)
#pragma unroll
            for (int m = 0; m < 4; ++m) { const int row = row0 + ai * HALF + m * 16; const float w8 = pw[ai * 4 + m] * sc; unsigned char* rowp = Y + (size_t)row * D + col0; int w[4];
#pragma unroll
                for (int bj = 0; bj < 2; ++bj)
#pragma unroll
                    for (int n = 0; n < 2; ++n) { const f32x4 v = acc[ai][bj][m][n] * w8;
                        int x = __builtin_amdgcn_cvt_pk_fp8_f32(v[0], v[1], 0, false); x = __builtin_amdgcn_cvt_pk_fp8_f32(v[2], v[3], x, true); w[bj * 2 + n] = x; }
                u32x4 o; o.x = (unsigned)w[0]; o.y = (unsigned)w[1]; o.z = (unsigned)w[2]; o.w = (unsigned)w[3]; *(u32x4*)rowp = o; }
    }
};
}

namespace att {
constexpr int NW = 8, QBLK = 32, KVBLK = 64;
constexpr int KRING = 8 * 4096, VRING = 12 * 8192;
constexpr int SHM_ATTN = KRING + VRING + NW * 64 * 4;
typedef int i32x8 __attribute__((ext_vector_type(8)));
typedef short s16x2 __attribute__((ext_vector_type(2)));
#define SBAR() __builtin_amdgcn_sched_barrier(0)
DI int crow(int r, int hi) { return (r & 3) + 8 * (r >> 2) + 4 * hi; }

template <int MAP>
DI void attn_pass(const unsigned char* __restrict__ Q8, const char* __restrict__ Kimg, const char* __restrict__ Vimg, bf16_t* __restrict__ Yb, u32x4* __restrict__ park, float lam, const float* __restrict__ sgv,
                  int NT, char* lds, LAS unsigned char* ldsl, int wv) {
    const int tid = opaque_tid(wv), wid = __builtin_amdgcn_readfirstlane(tid >> 6), lane = tid & 63, r32 = lane & 31, hi = lane >> 5;
    f32x16 o[4], o4; i32x8 B5, QF;
#pragma unroll
    for (int d = 0; d < 4; ++d)
#pragma unroll
        for (int r = 0; r < 16; ++r) o[d][r] = 0.f;
#pragma unroll
    for (int r = 0; r < 16; ++r) o4[r] = 0.f;
#pragma unroll
    for (int i = 0; i < 8; ++i) B5[i] = (r32 == 0 || r32 == 4) ? 0x38383838 : 0;
    { const u32x4 qa = *reinterpret_cast<const u32x4*>(Q8 + (size_t)(wid * QBLK + r32) * 1024 + hi * 32), qb = *reinterpret_cast<const u32x4*>(Q8 + (size_t)(wid * QBLK + r32) * 1024 + hi * 32 + 16);
      QF = (i32x8){(int)qa.x, (int)qa.y, (int)qa.z, (int)qa.w, (int)qb.x, (int)qb.y, (int)qb.z, (int)qb.w}; }
    asm volatile("s_waitcnt vmcnt(0)" ::: "memory");
    const unsigned goff = (unsigned)wid * 1024u + (unsigned)lane * 16u, ldsw = (unsigned)wid * 1024u, lds32 = (unsigned)(size_t)ldsl;
    const int sw = (r32 >> 2) & 3, vo0 = r32 * 64 + (((2 * hi) ^ sw) << 4), vo1 = r32 * 64 + (((2 * hi + 1) ^ sw) << 4);
    const bool kw = wid < 4;
#define DMAG(gp, m0v) asm volatile("s_nop 0\n\tglobal_load_lds_dwordx4 %0, %1" :: "v"(goff), "s"(gp), "{m0}"(m0v) : "memory")
#define DMA1(t, vs) do { \
    if (kw) DMAG(Kimg + (size_t)(t) * 4096, lds32 + (((unsigned)(t) & 7u) << 12) + ldsw); \
    DMAG(Vimg + (size_t)(t) * 8192, lds32 + (unsigned)KRING + ((unsigned)(vs) << 13) + ldsw); } while (0)
#define DMA4(t0, vs0) do { _Pragma("unroll") for (int _j = 0; _j < 4; ++_j) DMA1((t0) + _j, (vs0) + _j); } while (0)
#define KST(t) (lds + (((t) & 7) << 12))
#define VSTG(s) (lds + KRING + ((s) << 13))
#define LD16(p) (*reinterpret_cast<const u32x4*>(p))
#define MK8(va, vb) (i32x8){(int)va.x, (int)va.y, (int)va.z, (int)va.w, (int)vb.x, (int)vb.y, (int)vb.z, (int)vb.w}
#define M64(P, va, vb, d0) o[d0] = __builtin_amdgcn_mfma_scale_f32_32x32x64_f8f6f4(MK8(va, vb), P, o[d0], 0, 1, 0, 0, 0, 0)
#define MQK(ka, kb, acc) acc = __builtin_amdgcn_mfma_scale_f32_32x32x64_f8f6f4(MK8(ka, kb), QF, (f32x16){0.f, 0.f, 0.f, 0.f, 0.f, 0.f, 0.f, 0.f, 0.f, 0.f, 0.f, 0.f, 0.f, 0.f, 0.f, 0.f}, 0, 0, 0, 0, 0, 0)
#define PINF(x) asm volatile("" : "+v"(x))
#define EX1(S0, S1, e) do { if ((e) < 16) { S0[(e) & 15] = __builtin_amdgcn_exp2f(S0[(e) & 15]); PINF(S0[(e) & 15]); } else { S1[(e) & 15] = __builtin_amdgcn_exp2f(S1[(e) & 15]); PINF(S1[(e) & 15]); } } while (0)
#define EX4(S0, S1, e) do { EX1(S0, S1, e); EX1(S0, S1, (e) + 1); EX1(S0, S1, (e) + 2); EX1(S0, S1, (e) + 3); } while (0)
#define CVD(u) const int u = 0
#define CV2(a, b, c, d, dst, u) do { typedef __fp16 h2_t __attribute__((ext_vector_type(2))); const h2_t _x = __builtin_amdgcn_cvt_pkrtz(a, b), _y = __builtin_amdgcn_cvt_pkrtz(c, d); (void)u; \
    dst = (int)__builtin_amdgcn_perm(__builtin_bit_cast(unsigned, _y), __builtin_bit_cast(unsigned, _x), 0x07050301u); } while (0)
#define PIN6(PN) do { PINF(PN[0]); PINF(PN[1]); PINF(PN[2]); PINF(PN[3]); PINF(PN[4]); PINF(PN[5]); } while (0)
#define CVW(S0, S1, PN, i, u) do { if ((i) < 4) CV2(S0[(4 * (i)) & 15], S0[(4 * (i) + 1) & 15], S0[(4 * (i) + 2) & 15], S0[(4 * (i) + 3) & 15], PN[i], u); \
    else CV2(S1[(4 * (i)) & 15], S1[(4 * (i) + 1) & 15], S1[(4 * (i) + 2) & 15], S1[(4 * (i) + 3) & 15], PN[i], u); } while (0)
#define LOADK(t) do { const char* const _k = KST(t); ka0 = LD16(_k + vo0); ka1 = LD16(_k + vo1); kb0 = LD16(_k + 2048 + vo0); kb1 = LD16(_k + 2048 + vo1); } while (0)
#define ITER(DOQK, DOSM, DOPV, NXPV, NXQK, SN0, SN1, SP0, SP1, PN, PO, t, vstage, vnext) do { \
    u32x4 vc0, vc1, vd0, vd1; \
    const char* const vsb = VSTG(vstage); const char* const vsn = VSTG(vnext); const char* const ksn = KST((t) + 1); \
    SBAR(); \
    if (DOPV) M64(PO, va0, va1, 0); if (DOPV) { vc0 = LD16(vsb + 4096 + vo0); vc1 = LD16(vsb + 4096 + vo1); } if (DOSM) { EX4(SP0, SP1, 0); EX1(SP0, SP1, 4); EX1(SP0, SP1, 5); } \
    SBAR(); \
    if (DOPV) M64(PO, vb0, vb1, 1); if (DOPV) { vd0 = LD16(vsb + 6144 + vo0); vd1 = LD16(vsb + 6144 + vo1); } if (DOSM) { CVD(u0); EX4(SP0, SP1, 6); EX1(SP0, SP1, 10); EX1(SP0, SP1, 11); CVW(SP0, SP1, PN, 0, u0); } \
    SBAR(); \
    if (DOQK) { MQK(ka0, ka1, SN0); } if (NXPV) { va0 = LD16(vsn + vo0); va1 = LD16(vsn + vo1); } if (DOSM) { CVD(u1); CVD(u2); EX4(SP0, SP1, 12); CVW(SP0, SP1, PN, 1, u1); CVW(SP0, SP1, PN, 2, u2); } \
    SBAR(); \
    if (DOQK) { MQK(kb0, kb1, SN1); } if (NXPV) { vb0 = LD16(vsn + 2048 + vo0); vb1 = LD16(vsn + 2048 + vo1); } if (DOSM) { CVD(u3); EX4(SP0, SP1, 16); CVW(SP0, SP1, PN, 3, u3); } \
    SBAR(); \
    if (DOPV) M64(PO, vc0, vc1, 2); if (NXQK) { ka0 = LD16(ksn + vo0); ka1 = LD16(ksn + vo1); } if (DOSM) { CVD(u4); EX4(SP0, SP1, 20); CVW(SP0, SP1, PN, 4, u4); } \
    SBAR(); \
    if (DOPV) M64(PO, vd0, vd1, 3); if (NXQK) { kb0 = LD16(ksn + 2048 + vo0); kb1 = LD16(ksn + 2048 + vo1); } if (DOSM) { CVD(u5); EX4(SP0, SP1, 24); CVW(SP0, SP1, PN, 5, u5); } \
    SBAR(); \
    if (DOPV) o4 = __builtin_amdgcn_mfma_scale_f32_32x32x64_f8f6f4(B5, PO, o4, 0, 1, 0, 0, 0, 0); if (DOSM) { CVD(u6); CVD(u7); EX4(SP0, SP1, 28); CVW(SP0, SP1, PN, 6, u6); CVW(SP0, SP1, PN, 7, u7); PIN6(PN); } \
    SBAR(); } while (0)
#define ITERQ(DOQK, DOSM, DOPV, NXPV, NXQK, SN0, SN1, SP0, SP1, PN, PO, t, vstage, vnext) do { \
    u32x4 vc0, vc1, vd0, vd1; \
    const char* const vsb = VSTG(vstage); const char* const vsn = VSTG(vnext); const char* const ksn = KST((t) + 1); \
    SBAR(); \
    if (DOQK) { MQK(ka0, ka1, SN0); } if (DOPV) { vc0 = LD16(vsb + 4096 + vo0); vc1 = LD16(vsb + 4096 + vo1); } if (DOSM) { EX4(SP0, SP1, 0); EX1(SP0, SP1, 4); EX1(SP0, SP1, 5); } \
    SBAR(); \
    if (DOQK) { MQK(kb0, kb1, SN1); } if (DOPV) { vd0 = LD16(vsb + 6144 + vo0); vd1 = LD16(vsb + 6144 + vo1); } if (DOSM) { CVD(u0); EX4(SP0, SP1, 6); EX1(SP0, SP1, 10); EX1(SP0, SP1, 11); CVW(SP0, SP1, PN, 0, u0); } \
    SBAR(); \
    if (DOPV) M64(PO, va0, va1, 0); if (NXQK) { ka0 = LD16(ksn + vo0); ka1 = LD16(ksn + vo1); } if (DOSM) { CVD(u1); CVD(u2); EX4(SP0, SP1, 12); CVW(SP0, SP1, PN, 1, u1); CVW(SP0, SP1, PN, 2, u2); } \
    SBAR(); \
    if (DOPV) M64(PO, vb0, vb1, 1); if (NXQK) { kb0 = LD16(ksn + 2048 + vo0); kb1 = LD16(ksn + 2048 + vo1); } if (DOSM) { CVD(u3); EX4(SP0, SP1, 16); CVW(SP0, SP1, PN, 3, u3); } \
    SBAR(); \
    if (DOPV) M64(PO, vc0, vc1, 2); if (NXPV) { va0 = LD16(vsn + vo0); va1 = LD16(vsn + vo1); } if (DOSM) { CVD(u4); EX4(SP0, SP1, 20); CVW(SP0, SP1, PN, 4, u4); } \
    SBAR(); \
    if (DOPV) M64(PO, vd0, vd1, 3); if (NXPV) { vb0 = LD16(vsn + 2048 + vo0); vb1 = LD16(vsn + 2048 + vo1); } if (DOSM) { CVD(u5); EX4(SP0, SP1, 24); CVW(SP0, SP1, PN, 5, u5); } \
    SBAR(); \
    if (DOPV) o4 = __builtin_amdgcn_mfma_scale_f32_32x32x64_f8f6f4(B5, PO, o4, 0, 1, 0, 0, 0, 0); if (DOSM) { CVD(u6); CVD(u7); EX4(SP0, SP1, 28); CVW(SP0, SP1, PN, 6, u6); CVW(SP0, SP1, PN, 7, u7); PIN6(PN); } \
    SBAR(); } while (0)
    f32x16 SA0, SA1, SB0, SB1; i32x8 PE, PD;
#pragma unroll
    for (int i = 0; i < 8; ++i) { PE[i] = 0; PD[i] = 0; }
#define GROUP_SYNC(base, bn) do { asm volatile("s_waitcnt vmcnt(0)" ::: "memory"); __builtin_amdgcn_s_barrier(); LOADK(base); } while (0)
    u32x4 va0, va1, vb0, vb1, ka0, ka1, kb0, kb1;
    va0 = va1 = vb0 = vb1 = (u32x4){0u, 0u, 0u, 0u};
    DMA4(0, 0);
    GROUP_SYNC(0, 4);
    const bool more0 = 4 < NT;
    if (more0) DMA1(4, 4);
    ITER(true, false, false, false, true, SA0, SA1, SB0, SB1, PD, PE, 0, 0, 0);
    if (more0) DMA1(5, 5);
    ITERQ(true, true, false, true, true, SB0, SB1, SA0, SA1, PE, PD, 1, 0, 0);
    if (more0) { DMA1(6, 6); DMA1(7, 7); }
    ITERQ(true, true, true, true, true, SA0, SA1, SB0, SB1, PD, PE, 2, 0, 1);
    ITERQ(true, true, true, true, false, SB0, SB1, SA0, SA1, PE, PD, 3, 1, 2);
    int bp = 0, bm = 4, bn = 8;
    for (int base = 4; base < NT; base += 4) {
        GROUP_SYNC(base, bn);
        const bool more = base + 4 < NT;
        if (more) DMA1(base + 4, bn);
        ITER(true, true, true, true, true, SA0, SA1, SB0, SB1, PD, PE, base, bp + 2, bp + 3);
        if (more) DMA1(base + 5, bn + 1);
        ITERQ(true, true, true, true, true, SB0, SB1, SA0, SA1, PE, PD, base + 1, bp + 3, bm);
        if (more) { DMA1(base + 6, bn + 2); DMA1(base + 7, bn + 3); }
        ITERQ(true, true, true, true, true, SA0, SA1, SB0, SB1, PD, PE, base + 2, bm, bm + 1);
        ITERQ(true, true, true, true, false, SB0, SB1, SA0, SA1, PE, PD, base + 3, bm + 1, bm + 2);
        bp = bm; bm = bn; bn = (bn == 8) ? 0 : bn + 4;
    }
    ITER(false, true, true, true, false, SA0, SA1, SB0, SB1, PD, PE, NT, bp + 2, bp + 3);
    ITER(false, false, true, false, false, SB0, SB1, SA0, SA1, PE, PD, NT + 1, bp + 3, 0);
#undef GROUP_SYNC
#undef LOADK
    const float rl = __builtin_amdgcn_rcpf(o4[0]);
    if (MAP == 0) {
#pragma unroll
        for (int d0 = 0; d0 < 4; ++d0)
#pragma unroll
            for (int q = 0; q < 2; ++q) { u32x4 w;
                w.x = pk2(o[d0][8 * q + 0] * rl, o[d0][8 * q + 1] * rl); w.y = pk2(o[d0][8 * q + 2] * rl, o[d0][8 * q + 3] * rl);
                w.z = pk2(o[d0][8 * q + 4] * rl, o[d0][8 * q + 5] * rl); w.w = pk2(o[d0][8 * q + 6] * rl, o[d0][8 * q + 7] * rl);
                park[d0 * 2 + q] = w; }
    } else {
        float ss = 0.f; const float lrl = lam * rl;
#pragma unroll
        for (int d0 = 0; d0 < 4; ++d0)
#pragma unroll
            for (int q = 0; q < 2; ++q) { const u32x4 w = park[d0 * 2 + q]; const unsigned ww[4] = {w.x, w.y, w.z, w.w};
#pragma unroll
                for (int e = 0; e < 4; ++e) { const int r = 8 * q + 2 * e;
                    o[d0][r] = bflo(ww[e]) - lrl * o[d0][r]; o[d0][r + 1] = bfhi(ww[e]) - lrl * o[d0][r + 1];
                    ss += o[d0][r] * o[d0][r] + o[d0][r + 1] * o[d0][r + 1]; } }
        ss += __shfl_xor(ss, 32);
        const float rn = rsqrtf(ss * (1.0f / 128.0f) + EPS);
        bf16_t* Yw = Yb + (size_t)(wid * QBLK + r32) * D + 4 * hi;
#pragma unroll
        for (int d0 = 0; d0 < 4; ++d0)
#pragma unroll
            for (int j = 0; j < 4; ++j) { const f32x4 g = *(const f32x4*)(sgv + d0 * 32 + 8 * j + 4 * hi);
                u32x2 w; w.x = pk2(o[d0][4 * j] * rn * g[0], o[d0][4 * j + 1] * rn * g[1]); w.y = pk2(o[d0][4 * j + 2] * rn * g[2], o[d0][4 * j + 3] * rn * g[3]);
                *(u32x2*)(Yw + d0 * 32 + 8 * j) = w; }
    }
    __builtin_amdgcn_s_barrier();
#undef DMA4
#undef DMA1
#undef DMAG
#undef KST
#undef VSTG
#undef LD16
#undef MK8
#undef M64
#undef MQK
#undef EX1
#undef EX4
#undef PINF
#undef CVW
#undef PIN6
#undef CV2
#undef CVD
#undef ITER
#undef ITERQ
}
DI void attn_unit(const unsigned char* Q8m, const char* Kimgm, const char* Vimg, bf16_t* Yb, u32x4* park, float lam, const float* sgv, int NT, char* lds, LAS unsigned char* ldsl, int wv) {
    attn_pass<0>(Q8m, Kimgm, Vimg, Yb, park, lam, sgv, NT, lds, ldsl, wv);
    attn_pass<1>(Q8m + 64, Kimgm + (size_t)NTILE * 4096, Vimg, Yb, park, lam, sgv, NT, lds, ldsl, wv);
}
}

struct Args { const float* in[29]; float* out; unsigned char* ws; int ph_lo, ph_hi; };
struct Frame {
    const Args& a; size_t z; char* lds; int G, vcu, wv;
    DI const float* x() const { return a.in[0] + z; }
    DI const float* c() const { return a.in[1] + z; }
    DI const float* ctx() const { return a.in[2] + z; }
    DI const float* c_ctx() const { return a.in[3] + z; }
    DI const float* ada_w() const { return a.in[4] + z; }
    DI const float* ada_b() const { return a.in[5] + z; }
    DI const float* norm1_g() const { return a.in[6] + z; }
    DI const float* norm2_g() const { return a.in[7] + z; }
    DI const float* w_in() const { return a.in[8] + z; }
    DI const float* q_norm_g() const { return a.in[9] + z; }
    DI const float* k_norm_g() const { return a.in[10] + z; }
    DI const float* lam_q1() const { return a.in[11] + z; }
    DI const float* lam_k1() const { return a.in[12] + z; }
    DI const float* lam_q2() const { return a.in[13] + z; }
    DI const float* lam_k2() const { return a.in[14] + z; }
    DI const float* subln_g() const { return a.in[15] + z; }
    DI const float* pool_w() const { return a.in[16] + z; }
    DI const float* pool_scale() const { return a.in[17] + z; }
    DI const float* gmlp_norm_g() const { return a.in[18] + z; }
    DI const float* gmlp_ws() const { return a.in[19] + z; }
    DI const float* gmlp_bs() const { return a.in[20] + z; }
    DI const float* w_out() const { return a.in[21] + z; }
    DI const float* router_g_w() const { return a.in[22] + z; }
    DI const float* router_g_b() const { return a.in[23] + z; }
    DI const float* router_e_w() const { return a.in[24] + z; }
    DI const float* router_e_b() const { return a.in[25] + z; }
    DI const float* w_gate() const { return a.in[26] + z; }
    DI const float* w_up() const { return a.in[27] + z; }
    DI const float* w_down() const { return a.in[28] + z; }
    DI float* out() const { return a.out + z; }
    DI unsigned* ctl() const { return (unsigned*)(a.ws + z + WS_CTL); }
    DI float* MOD() const { return (float*)(a.ws + z + WS_MOD); }
    DI float* LAM() const { return (float*)(a.ws + z + WS_LAM); }
    DI float* ROPE() const { return (float*)(a.ws + z + WS_ROPE); }
    DI bf16_t* WSB() const { return (bf16_t*)(a.ws + z + WS_WSB); }
    DI bf16_t* PWT() const { return (bf16_t*)(a.ws + z + WS_PWT); }
    DI bf16_t* RWT() const { return (bf16_t*)(a.ws + z + WS_RWT); }
    DI bf16_t* WIN() const { return (bf16_t*)(a.ws + z + WS_WIN); }
    DI bf16_t* WOUT() const { return (bf16_t*)(a.ws + z + WS_WOUT); }
    DI bf16_t* GU() const { return (bf16_t*)(a.ws + z + WS_GU); }
    DI bf16_t* WD() const { return (bf16_t*)(a.ws + z + WS_WD); }
    DI bf16_t* ACT() const { return (bf16_t*)(a.ws + z + WS_ACT); }
    DI bf16_t* PROJ() const { return (bf16_t*)(a.ws + z + WS_PROJ); }
    DI unsigned char* PROJ8() const { return (unsigned char*)(a.ws + z + WS_PROJ); }
    DI bf16_t* PROJ16() const { return (bf16_t*)(a.ws + z + WS_PROJ + al256((size_t)TV * 3072)); }
    DI bf16_t* YBUF() const { return (bf16_t*)(a.ws + z + WS_PROJ); }
    DI bf16_t* HID() const { return (bf16_t*)(a.ws + z + WS_OPART + OFF_HID); }
    DI float* OPART() const { return (float*)(a.ws + z + WS_OPART); }
    DI float* LOGITS() const { return (float*)(a.ws + z + WS_OPART + OFF_LOGITS); }
    DI bf16_t* XB() const { return (bf16_t*)(a.ws + z + WS_XB); }
    DI float* ASGW() const { return (float*)(a.ws + z + WS_ASGW); }
    DI float* BUFW() const { return (float*)(a.ws + z + WS_BUFW); }
    DI int* ASGE() const { return (int*)(a.ws + z + WS_ASGE); }
    DI int* ASGP() const { return (int*)(a.ws + z + WS_ASGP); }
    DI int* SLOT() const { return (int*)(a.ws + z + WS_SLOT); }
    DI int* BUFT() const { return (int*)(a.ws + z + WS_BUFT); }
    DI int* BLKE() const { return (int*)(a.ws + z + WS_BLKE); }
    DI unsigned char* ACT8() const { return (unsigned char*)(a.ws + z + WS_OPART + OFF_ACT8); }
    DI unsigned char* Q8() const { return (unsigned char*)(a.ws + z + WS_Q8); }
    DI u32x4* PARK() const { return (u32x4*)(a.ws + z + WS_PARK); }
    DI char* KIMG() const { return (char*)(a.ws + z + WS_KIMG); }
    DI char* VIMG() const { return (char*)(a.ws + z + WS_VIMG); }
};

DI Frame fresh(const Frame& F) {
    size_t z = 0; int g = F.G, v = F.vcu, w = F.wv;
    asm volatile("" : "+s"(z), "+s"(g), "+s"(v), "+s"(w));
    return Frame{F.a, z, F.lds, g, v, w};
}
DI bool row_isctx(int r) { const int j = r >= SEQV ? r - SEQV : r; return j < CTX; }
DI size_t row_off(int r, bool& isctx, int& b) { b = r >= SEQV; const int j = r - b * SEQV; isctx = j < CTX; return isctx ? (size_t)(b * CTX + j) * D : (size_t)(b * SEQ + j - CTX) * D; }

struct TileD { const float* sp; char* dp; float scale; int is8; };
DI TileD tile_desc(const Frame& F, int u, int t) {
    constexpr int C0 = 2 * 32 * 72, C1 = C0 + 2 * 32 * 32, C2 = C1 + 64 * 256, C3 = C2 + 64 * 256, C4 = C3 + 64 * 256;
    const float* src; char* dst; int ldsrc, lddst, k0, n0, drow0, is8 = 1; float scale = 32.0f;
    if (u < C0) { const int l = u / 2304, r = u % 2304, kt = r / 72, nt = r % 72;
        src = F.w_in() + (size_t)l * D * INC; ldsrc = INC; dst = (char*)F.WIN() + (size_t)l * INC * D; lddst = D; k0 = kt * 64; n0 = nt * 64; drow0 = n0; }
    else if (u < C1) { const int v = u - C0, l = v / 1024, r = v % 1024, kt = r / 32, nt = r % 32;
        src = F.w_out() + (size_t)l * D * D; ldsrc = D; dst = (char*)(F.WOUT() + (size_t)l * D * D); lddst = D; k0 = kt * 64; n0 = nt * 64; drow0 = n0; is8 = 0; }
    else if (u < C3) { const bool up = u >= C2; const int v = u - (up ? C2 : C1), le = v / 256, r = v % 256, kt = r / 8, nt = r % 8;
        src = (up ? F.w_up() : F.w_gate()) + (size_t)le * D * FF; ldsrc = FF; dst = (char*)F.GU() + (size_t)le * 1024 * D; lddst = D; k0 = kt * 64; n0 = nt * 64; drow0 = (n0 >> 7) * 256 + (up ? 128 : 0) + (n0 & 127); }
    else if (u < C4) { const int v = u - C3, le = v / 256, r = v % 256, kt = r / 32, nt = r % 32;
        src = F.w_down() + (size_t)le * FF * D; ldsrc = D; dst = (char*)F.WD() + (size_t)le * D * FF; lddst = FF; k0 = kt * 64; n0 = nt * 64; drow0 = n0; scale = 16.0f; }
    else { const int v = u - C4, lg = v / 4, r = v % 4, kt = r / 2, nt = r % 2;
        src = F.pool_w() + (size_t)lg * 128 * 128; ldsrc = 128; dst = (char*)(F.PWT() + (size_t)lg * 128 * 128); lddst = 128; k0 = kt * 64; n0 = nt * 64; drow0 = n0; is8 = 0; }
    const int hi = t >> 3, lo8 = (t & 7) * 8;
    TileD d; d.sp = src + (size_t)(k0 + hi) * ldsrc + n0 + lo8; d.dp = dst + ((size_t)(drow0 + hi) * lddst + k0 + lo8) * (is8 ? 1 : 2); d.scale = scale; d.is8 = is8;
    return d;
}
DI void tile_process(const Frame& F, int t, const TileD& d, f32x4 a, f32x4 b) {
    const int kr = t >> 3, nc = (t & 7) * 8;
    if (d.is8) {
        unsigned char* T = (unsigned char*)F.lds;
        a *= d.scale; b *= d.scale;
        const unsigned p0 = (unsigned)__builtin_amdgcn_cvt_pk_fp8_f32(a[0], a[1], 0, false), p1 = (unsigned)__builtin_amdgcn_cvt_pk_fp8_f32(a[2], a[3], 0, false);
        const unsigned p2 = (unsigned)__builtin_amdgcn_cvt_pk_fp8_f32(b[0], b[1], 0, false), p3 = (unsigned)__builtin_amdgcn_cvt_pk_fp8_f32(b[2], b[3], 0, false);
        T[(nc + 0) * 72 + kr] = (unsigned char)p0; T[(nc + 1) * 72 + kr] = (unsigned char)(p0 >> 8); T[(nc + 2) * 72 + kr] = (unsigned char)p1; T[(nc + 3) * 72 + kr] = (unsigned char)(p1 >> 8);
        T[(nc + 4) * 72 + kr] = (unsigned char)p2; T[(nc + 5) * 72 + kr] = (unsigned char)(p2 >> 8); T[(nc + 6) * 72 + kr] = (unsigned char)p3; T[(nc + 7) * 72 + kr] = (unsigned char)(p3 >> 8);
        __syncthreads();
        const u32x2 w = *(const u32x2*)(T + kr * 72 + nc);
        *(u32x2*)d.dp = w;
        __syncthreads();
    } else {
        bf16_t* T = (bf16_t*)F.lds;
        const unsigned p0 = pk2(a[0], a[1]), p1 = pk2(a[2], a[3]), p2 = pk2(b[0], b[1]), p3 = pk2(b[2], b[3]);
        T[(nc + 0) * 66 + kr] = (bf16_t)p0; T[(nc + 1) * 66 + kr] = (bf16_t)(p0 >> 16); T[(nc + 2) * 66 + kr] = (bf16_t)p1; T[(nc + 3) * 66 + kr] = (bf16_t)(p1 >> 16);
        T[(nc + 4) * 66 + kr] = (bf16_t)p2; T[(nc + 5) * 66 + kr] = (bf16_t)(p2 >> 16); T[(nc + 6) * 66 + kr] = (bf16_t)p3; T[(nc + 7) * 66 + kr] = (bf16_t)(p3 >> 16);
        __syncthreads();
        const unsigned* Tw = (const unsigned*)(T + kr * 66 + nc);
        u32x4 w; w.x = Tw[0]; w.y = Tw[1]; w.z = Tw[2]; w.w = Tw[3];
        *(u32x4*)d.dp = w;
        __syncthreads();
    }
}
DI void phase_prologue(const Frame& F) {
    const int t = opaque_tid(F.wv), bx = blockIdx.x, G = F.G;
    {
        constexpr int C5 = 2 * 32 * 72 + 2 * 32 * 32 + 3 * 64 * 256 + 32;
        TileD d0 = tile_desc(F, bx < C5 ? bx : 0, t), d1 = tile_desc(F, bx + G < C5 ? bx + G : 0, t);
        f32x4 a0 = *(const f32x4*)d0.sp, b0 = *(const f32x4*)(d0.sp + 4), a1 = *(const f32x4*)d1.sp, b1 = *(const f32x4*)(d1.sp + 4);
        for (int u = bx; u < C5; u += G) {
            const int u2 = u + 2 * G;
            const TileD d2 = tile_desc(F, u2 < C5 ? u2 : 0, t);
            const f32x4 a2 = *(const f32x4*)d2.sp, b2 = *(const f32x4*)(d2.sp + 4);
            tile_process(F, t, d0, a0, b0);
            d0 = d1; a0 = a1; b0 = b1; d1 = d2; a1 = a2; b1 = b2;
        }
    }
    {
        float* sv = (float*)F.lds;
        float* red = sv + 3 * D;
        __syncthreads();
        for (int i = t; i < 3 * D; i += 512) { const int v = i / D, k = i % D; const float cv = v < 2 ? F.c()[v * D + k] : F.c_ctx()[k]; sv[i] = silu_f(cv); }
        __syncthreads();
        const int cg = t & 7, kl = t >> 3;
        for (int u = bx; u < 768; u += G) {
            const int l = u / 384, n0 = (u % 384) * 32;
            const float* W = F.ada_w() + (size_t)l * D * 6 * D + n0 + cg * 4;
            f32x4 a0 = {0, 0, 0, 0}, a1 = a0, a2 = a0;
#pragma unroll 8
            for (int k = kl; k < D; k += 64) { const f32x4 w = *(const f32x4*)(W + (size_t)k * 6 * D); a0 += w * sv[k]; a1 += w * sv[D + k]; a2 += w * sv[2 * D + k]; }
            float* rp = red + (kl * 8 + cg) * 12;
            *(f32x4*)(rp) = a0; *(f32x4*)(rp + 4) = a1; *(f32x4*)(rp + 8) = a2;
            __syncthreads();
            if (t < 96) { const int v = t / 32, cc = t % 32, cgg = cc >> 2, j = cc & 3; float s = 0.f;
                for (int q = 0; q < 64; ++q) s += red[(q * 8 + cgg) * 12 + v * 4 + j];
                F.MOD()[((size_t)l * 3 + v) * 6 * D + n0 + cc] = s + F.ada_b()[(size_t)l * 6 * D + n0 + cc]; }
            __syncthreads();
        }
    }
    const int gt = bx * 512 + t, GT = G * 512;
    for (int i = gt; i < 2 * 4 * 128 * 128; i += GT) F.WSB()[i] = (bf16_t)pk2(F.gmlp_ws()[i], 0.f);
    for (int i = gt; i < 256 * 16; i += GT) { const int pos = i >> 4, k = i & 15; const float inv = powf(10000.0f, -(float)k / 16.0f); const float ang = (float)pos * inv;
        F.ROPE()[i] = cosf(ang); F.ROPE()[256 * 16 + i] = sinf(ang); }
    for (int i = gt; i < 2 * 256 * D; i += GT) { const int l = i / (256 * D), r = (i / D) % 256, k = i % D; float v = 0.f;
        if (r < 4) v = F.router_g_w()[((size_t)l * D + k) * 4 + r]; else if (r < 36) v = F.router_e_w()[((size_t)l * D + k) * 32 + (r - 4)];
        F.RWT()[i] = (bf16_t)pk2(v, 0.f); }
    if (bx == 0 && t < 128) {
        const int l = t >> 6, k = t & 63;
        const float s1 = wave_sum(F.lam_q1()[l * 64 + k] * F.lam_k1()[l * 64 + k]), s2 = wave_sum(F.lam_q2()[l * 64 + k] * F.lam_k2()[l * 64 + k]);
        if (k == 0) F.LAM()[l] = expf(s1) - expf(s2) + (l == 0 ? 0.2f : 0.8f - 0.6f * 0.7408182206817179f);
    }
}

DI float sumsq8(const f32x4 (&v)[8]) {
    float ss = 0.f;
#pragma unroll
    for (int i = 0; i < 8; ++i) ss += v[i][0] * v[i][0] + v[i][1] * v[i][1] + v[i][2] * v[i][2] + v[i][3] * v[i][3];
    return ss;
}
DI int CI8(int lane, int i) { return (i >> 1) * 512 + lane * 8 + (i & 1) * 4; }
DI void ysum8(const unsigned char* y0, const unsigned char* y1, int cidx, f32x4& lo, f32x4& hi) {
    typedef float f2 __attribute__((ext_vector_type(2)));
    const u32x2 a = *(const u32x2*)(y0 + cidx), bb = *(const u32x2*)(y1 + cidx);
    const f2 a0 = __builtin_amdgcn_cvt_pk_f32_fp8(a.x, false), a1 = __builtin_amdgcn_cvt_pk_f32_fp8(a.x, true), a2 = __builtin_amdgcn_cvt_pk_f32_fp8(a.y, false), a3 = __builtin_amdgcn_cvt_pk_f32_fp8(a.y, true);
    const f2 b0 = __builtin_amdgcn_cvt_pk_f32_fp8(bb.x, false), b1 = __builtin_amdgcn_cvt_pk_f32_fp8(bb.x, true), b2 = __builtin_amdgcn_cvt_pk_f32_fp8(bb.y, false), b3 = __builtin_amdgcn_cvt_pk_f32_fp8(bb.y, true);
    lo = (f32x4){a0[0] + b0[0], a0[1] + b0[1], a1[0] + b1[0], a1[1] + b1[1]}; hi = (f32x4){a2[0] + b2[0], a2[1] + b2[1], a3[0] + b3[0], a3[1] + b3[1]};
}
DI void unpack8(const u32x4 w, f32x4& lo, f32x4& hi) { lo = (f32x4){bflo(w.x), bfhi(w.x), bflo(w.y), bfhi(w.y)}; hi = (f32x4){bflo(w.z), bfhi(w.z), bflo(w.w), bfhi(w.w)}; }
DI u32x4 pack8(const f32x4 lo, const f32x4 hi) { u32x4 w; w.x = pk2(lo[0], lo[1]); w.y = pk2(lo[2], lo[3]); w.z = pk2(hi[0], hi[1]); w.w = pk2(hi[2], hi[3]); return w; }
DI u32x2 pack8f8(const f32x4 lo, const f32x4 hi) { int a = __builtin_amdgcn_cvt_pk_fp8_f32(lo[0], lo[1], 0, false); a = __builtin_amdgcn_cvt_pk_fp8_f32(lo[2], lo[3], a, true);
    int b = __builtin_amdgcn_cvt_pk_fp8_f32(hi[0], hi[1], 0, false); b = __builtin_amdgcn_cvt_pk_fp8_f32(hi[2], hi[3], b, true); u32x2 w; w.x = (unsigned)a; w.y = (unsigned)b; return w; }
template <int L> DI void phase_norm1(const Frame& F) {
    constexpr int NR = 2;
    const int tid = opaque_tid(F.wv), wave = tid >> 6, lane = tid & 63;
    const float* gN = F.norm1_g() + (size_t)L * D;
    int sl[NR][2];
#pragma unroll
    for (int q = 0; q < NR; ++q) { sl[q][0] = 0; sl[q][1] = 0; }
    if (L == 1) { const int r0 = (blockIdx.x * 8 + wave) * NR; if (r0 < TV) {
#pragma unroll
        for (int q = 0; q < NR; ++q) { sl[q][0] = F.SLOT()[(r0 + q) * 2]; sl[q][1] = F.SLOT()[(r0 + q) * 2 + 1]; } } }
    for (int r0 = (blockIdx.x * 8 + wave) * NR; r0 < TV; r0 += F.G * 8 * NR) {
        bool isctx; int b; const size_t off = row_off(r0, isctx, b);
        const float* m = F.MOD() + ((size_t)L * 3 + (isctx ? 2 : b)) * 6 * D;
        int sn[NR][2];
#pragma unroll
        for (int q = 0; q < NR; ++q) { sn[q][0] = 0; sn[q][1] = 0; }
        if (L == 1) { const int rn = r0 + F.G * 8 * NR; if (rn < TV) {
#pragma unroll
            for (int q = 0; q < NR; ++q) { sn[q][0] = F.SLOT()[(rn + q) * 2]; sn[q][1] = F.SLOT()[(rn + q) * 2 + 1]; } } }
        f32x4 v[NR][8];
        bf16_t* xb = F.XB() + (size_t)r0 * D;
        if (L == 0) { const float* xin = (isctx ? F.ctx() : F.x()) + off;
#pragma unroll
            for (int q = 0; q < NR; ++q)
#pragma unroll
                for (int i = 0; i < 8; ++i) v[q][i] = *(const f32x4*)(xin + (size_t)q * D + CI8(lane, i));
        } else {
            const float* g2 = F.MOD() + ((size_t)0 * 3 + (isctx ? 2 : b)) * 6 * D + 5 * D;
            f32x4 yy[NR][8];
#pragma unroll
            for (int q = 0; q < NR; ++q) { const int s0 = sl[q][0], s1 = sl[q][1];
                const unsigned char* y0 = (const unsigned char*)F.YBUF() + (size_t)s0 * D; const unsigned char* y1 = (const unsigned char*)F.YBUF() + (size_t)s1 * D;
#pragma unroll
                for (int k = 0; k < 4; ++k) { const int cidx = CI8(lane, 2 * k); unpack8(*(const u32x4*)(xb + (size_t)q * D + cidx), v[q][2 * k], v[q][2 * k + 1]); ysum8(y0, y1, cidx, yy[q][2 * k], yy[q][2 * k + 1]); } }
#pragma unroll
            for (int i = 0; i < 8; ++i) { const f32x4 gg = *(const f32x4*)(g2 + CI8(lane, i));
#pragma unroll
                for (int q = 0; q < NR; ++q) v[q][i] = v[q][i] + gg * yy[q][i]; }
        }
#pragma unroll
        for (int q = 0; q < NR; ++q)
#pragma unroll
            for (int k = 0; k < 4; ++k) *(u32x4*)(xb + (size_t)q * D + CI8(lane, 2 * k)) = pack8(v[q][2 * k], v[q][2 * k + 1]);
        float rs[NR];
#pragma unroll
        for (int q = 0; q < NR; ++q) rs[q] = sumsq8(v[q]);
#pragma unroll
        for (int o = 32; o >= 1; o >>= 1)
#pragma unroll
            for (int q = 0; q < NR; ++q) rs[q] += __shfl_xor(rs[q], o);
#pragma unroll
        for (int q = 0; q < NR; ++q) rs[q] = rsqrtf(rs[q] * (1.0f / D) + EPS);
        unsigned char* hp = (unsigned char*)F.ACT() + (size_t)r0 * D;
#pragma unroll
        for (int k = 0; k < 4; ++k) { const int cidx = CI8(lane, 2 * k);
            const f32x4 gn0 = *(const f32x4*)(gN + cidx), sh0 = *(const f32x4*)(m + cidx), sc0 = (*(const f32x4*)(m + D + cidx) + 1.0f) * gn0;
            const f32x4 gn1 = *(const f32x4*)(gN + cidx + 4), sh1 = *(const f32x4*)(m + cidx + 4), sc1 = (*(const f32x4*)(m + D + cidx + 4) + 1.0f) * gn1;
#pragma unroll
            for (int q = 0; q < NR; ++q) *(u32x2*)(hp + (size_t)q * D + cidx) = pack8f8(v[q][2 * k] * rs[q] * sc0 + sh0, v[q][2 * k + 1] * rs[q] * sc1 + sh1); }
#pragma unroll
        for (int q = 0; q < NR; ++q) { sl[q][0] = sn[q][0]; sl[q][1] = sn[q][1]; }
    }
}

DI void phase_norm2r(const Frame& F, int l) {
    constexpr int NR = 2, HP = 2056, NG = TV / 16;
    const int tid = opaque_tid(F.wv), wave = tid >> 6, lane = tid & 63, fr = lane & 15, fq = lane >> 4;
    const float* gN = F.norm2_g() + (size_t)l * D;
    for (int i = blockIdx.x * 512 + tid; i < NSLOT_MAX; i += F.G * 512) { F.BUFT()[i] = -1; F.BUFW()[i] = 0.f; }
    bf16_t* Ht = (bf16_t*)F.lds;
    float* PART = (float*)(F.lds + 66048);
    float* LOG = (float*)(F.lds + 66048 + 24576);
    bf16_t* GW = (bf16_t*)(F.lds + 66048 + 24576 + 3072);
    bf16x8 Bf[2][8];
    { const bf16_t* rw = F.RWT() + ((size_t)l * 256 + 4 + fr) * D + 256 * wave + 8 * fq;
#pragma unroll
      for (int nt = 0; nt < 2; ++nt)
#pragma unroll
          for (int ks = 0; ks < 8; ++ks) Bf[nt][ks] = *(const bf16x8*)(rw + (size_t)(16 * nt) * D + 32 * ks);
      for (int c = tid; c < 5 * 256; c += 512) { const int row = c >> 8, col = (c & 255) * 8;
          u32x4 w = (u32x4){0u, 0u, 0u, 0u}; if (row < 4) w = *(const u32x4*)(F.RWT() + ((size_t)l * 256 + row) * D + col);
          *(u32x4*)(GW + (size_t)row * HP + col) = w; } }
    const bf16_t* gwp = GW + (size_t)(fr < 4 ? fr : 4) * HP + 256 * wave + 8 * fq;
    int* lcnt = (int*)(F.lds + 114304);
    if (tid < 32) lcnt[tid] = 0;
    const float* gb = F.router_g_b() + l * 4; const float* eb = F.router_e_b() + l * 32;
    int g = blockIdx.x;
    while (g < NG && l == 1 && row_isctx(g * 16)) g += F.G;
    u32x4 raw[NR][4];
#pragma unroll
    for (int q = 0; q < NR; ++q)
#pragma unroll
        for (int i = 0; i < 4; ++i) raw[q][i] = (u32x4){0u, 0u, 0u, 0u};
    if (g < NG) { const bf16_t* xb = F.XB() + (size_t)(g * 16 + 2 * wave) * D;
#pragma unroll
        for (int q = 0; q < NR; ++q)
#pragma unroll
            for (int i = 0; i < 4; ++i) raw[q][i] = *(const u32x4*)(xb + (size_t)q * D + CI8(lane, 2 * i)); }
    while (g < NG) {
        const int r0 = g * 16 + 2 * wave;
        bool isctx; int b; row_off(r0, isctx, b);
        const float* m = F.MOD() + ((size_t)l * 3 + (isctx ? 2 : b)) * 6 * D;
        int gn = g + F.G;
        while (gn < NG && l == 1 && row_isctx(gn * 16)) gn += F.G;
        float rs[NR];
#pragma unroll
        for (int q = 0; q < NR; ++q) { float ss = 0.f;
#pragma unroll
            for (int i = 0; i < 4; ++i) { f32x4 a, c; unpack8(raw[q][i], a, c); ss += a[0] * a[0] + a[1] * a[1] + a[2] * a[2] + a[3] * a[3] + c[0] * c[0] + c[1] * c[1] + c[2] * c[2] + c[3] * c[3]; }
            rs[q] = ss; }
#pragma unroll
        for (int o = 32; o >= 1; o >>= 1)
#pragma unroll
            for (int q = 0; q < NR; ++q) rs[q] += __shfl_xor(rs[q], o);
#pragma unroll
        for (int q = 0; q < NR; ++q) rs[q] = rsqrtf(rs[q] * (1.0f / D) + EPS);
        unsigned char* h8 = F.ACT8() + (size_t)r0 * D;
#pragma unroll
        for (int k = 0; k < 4; ++k) { const int cidx = CI8(lane, 2 * k);
            const f32x4 gn0 = *(const f32x4*)(gN + cidx), sh0 = *(const f32x4*)(m + 3 * D + cidx), sc0 = (*(const f32x4*)(m + 4 * D + cidx) + 1.0f) * gn0;
            const f32x4 gn1 = *(const f32x4*)(gN + cidx + 4), sh1 = *(const f32x4*)(m + 3 * D + cidx + 4), sc1 = (*(const f32x4*)(m + 4 * D + cidx + 4) + 1.0f) * gn1;
#pragma unroll
            for (int q = 0; q < NR; ++q) { f32x4 xa, xc; unpack8(raw[q][k], xa, xc); const f32x4 h0 = xa * rs[q] * sc0 + sh0, h1 = xc * rs[q] * sc1 + sh1;
                *(u32x4*)(Ht + (size_t)(2 * wave + q) * HP + cidx) = pack8(h0, h1); *(u32x2*)(h8 + (size_t)q * D + cidx) = pack8f8(h0, h1); } }
        __syncthreads();
        if (gn < NG) { const bf16_t* xb = F.XB() + (size_t)(gn * 16 + 2 * wave) * D;
#pragma unroll
            for (int q = 0; q < NR; ++q)
#pragma unroll
                for (int i = 0; i < 4; ++i) raw[q][i] = *(const u32x4*)(xb + (size_t)q * D + CI8(lane, 2 * i)); }
        f32x4 acc[3];
#pragma unroll
        for (int nt = 0; nt < 3; ++nt) acc[nt] = (f32x4){0.f, 0.f, 0.f, 0.f};
#pragma unroll
        for (int ks = 0; ks < 8; ++ks) { const bf16x8 A = *(const bf16x8*)(Ht + (size_t)fr * HP + 256 * wave + 32 * ks + 8 * fq); const bf16x8 Bg = *(const bf16x8*)(gwp + 32 * ks);
#pragma unroll
            for (int nt = 0; nt < 2; ++nt) acc[nt] = __builtin_amdgcn_mfma_f32_16x16x32_bf16(A, Bf[nt][ks], acc[nt], 0, 0, 0);
            acc[2] = __builtin_amdgcn_mfma_f32_16x16x32_bf16(A, Bg, acc[2], 0, 0, 0); }
#pragma unroll
        for (int nt = 0; nt < 3; ++nt)
#pragma unroll
            for (int jj = 0; jj < 4; ++jj) PART[(wave * 16 + 4 * fq + jj) * 48 + 16 * nt + fr] = acc[nt][jj];
        __syncthreads();
        for (int p = tid; p < 768; p += 512) { float sacc = 0.f;
#pragma unroll
            for (int w = 0; w < 8; ++w) sacc += PART[w * 768 + p];
            LOG[p] = sacc; }
        __syncthreads();
        if (tid < 16) {
            const int tok = g * 16 + tid; const float* L = LOG + tid * 48;
            float gl[4]; const f32x4 g4 = *(const f32x4*)(L + 32);
#pragma unroll
            for (int i = 0; i < 4; ++i) gl[i] = g4[i] + gb[i];
            int gi = 0; float gm = gl[0];
#pragma unroll
            for (int i = 1; i < 4; ++i) if (gl[i] > gm) { gm = gl[i]; gi = i; }
            float gs = 0.f;
#pragma unroll
            for (int i = 0; i < 4; ++i) gs += expf(gl[i] - gm);
            const float gval = 1.0f / gs;
            float el[8]; const f32x4 ea = *(const f32x4*)(L + gi * 8), ebv = *(const f32x4*)(L + 4 + gi * 8);
#pragma unroll
            for (int i = 0; i < 4; ++i) { el[i] = ea[i] + eb[gi * 8 + i]; el[4 + i] = ebv[i] + eb[gi * 8 + 4 + i]; }
            int i0 = 0; float m0 = el[0];
#pragma unroll
            for (int i = 1; i < 8; ++i) if (el[i] > m0) { m0 = el[i]; i0 = i; }
            int i1 = -1; float m1 = -3.0e38f;
#pragma unroll
            for (int i = 0; i < 8; ++i) if (i != i0 && el[i] > m1) { m1 = el[i]; i1 = i; }
            const float x1 = expf(m1 - m0), den = 1.0f / (1.0f + x1);
            const int e0 = gi * 8 + i0, e1 = gi * 8 + i1;
            F.ASGE()[tok * 2] = e0; F.ASGE()[tok * 2 + 1] = e1;
            F.ASGW()[tok * 2] = gval * den; F.ASGW()[tok * 2 + 1] = gval * x1 * den;
            F.ASGP()[tok * 2] = atomicAdd(&lcnt[e0], 1); F.ASGP()[tok * 2 + 1] = atomicAdd(&lcnt[e1], 1);
        }
        g = gn;
    }
    __syncthreads();
    if (tid < 32) ((int*)F.LOGITS())[blockIdx.x * 32 + tid] = lcnt[tid];
}

DI void phase_final(const Frame& F) {
    constexpr int NR = 2;
    const int tid = opaque_tid(F.wv), wave = tid >> 6, lane = tid & 63;
    int sl[NR][2];
#pragma unroll
    for (int q = 0; q < NR; ++q) { sl[q][0] = 0; sl[q][1] = 0; }
    { const int r0 = (blockIdx.x * 8 + wave) * NR; if (r0 < TV) {
#pragma unroll
        for (int q = 0; q < NR; ++q) { sl[q][0] = F.SLOT()[(r0 + q) * 2]; sl[q][1] = F.SLOT()[(r0 + q) * 2 + 1]; } } }
    for (int r0 = (blockIdx.x * 8 + wave) * NR; r0 < TV; r0 += F.G * 8 * NR) {
        bool isctx; int b; const size_t off = row_off(r0, isctx, b);
        int scur[NR][2];
#pragma unroll
        for (int q = 0; q < NR; ++q) { scur[q][0] = sl[q][0]; scur[q][1] = sl[q][1]; }
        { const int rn = r0 + F.G * 8 * NR; if (rn < TV) {
#pragma unroll
            for (int q = 0; q < NR; ++q) { sl[q][0] = F.SLOT()[(rn + q) * 2]; sl[q][1] = F.SLOT()[(rn + q) * 2 + 1]; } } }
        if (isctx) continue;
        float* xp = F.out() + off; const bf16_t* xb = F.XB() + (size_t)r0 * D;
        const float* g2 = F.MOD() + ((size_t)1 * 3 + b) * 6 * D + 5 * D;
        f32x4 v[NR][8], yy[NR][8];
#pragma unroll
        for (int q = 0; q < NR; ++q) { const int s0 = scur[q][0], s1 = scur[q][1];
            const unsigned char* y0 = (const unsigned char*)F.YBUF() + (size_t)s0 * D; const unsigned char* y1 = (const unsigned char*)F.YBUF() + (size_t)s1 * D;
#pragma unroll
            for (int k = 0; k < 4; ++k) { const int cidx = CI8(lane, 2 * k); unpack8(*(const u32x4*)(xb + (size_t)q * D + cidx), v[q][2 * k], v[q][2 * k + 1]); ysum8(y0, y1, cidx, yy[q][2 * k], yy[q][2 * k + 1]); } }
#pragma unroll
        for (int i = 0; i < 8; ++i) { const int cidx = CI8(lane, i); const f32x4 gg = *(const f32x4*)(g2 + cidx);
#pragma unroll
            for (int q = 0; q < NR; ++q) *(f32x4*)(xp + (size_t)q * D + cidx) = v[q][i] + gg * yy[q][i]
                ; }
    }
}

DI void phase_slots(const Frame& F, int l) {
    const int tid = opaque_tid(F.wv), bx = blockIdx.x, G = F.G;
    int* ptot = (int*)F.lds; int* pbel = ptot + 512; int* tot = pbel + 512; int* bel = tot + 32; int* pstart = bel + 32; int* nb = pstart + 32;
    const int* CNTM = (const int*)F.LOGITS();
    __syncthreads();
    { const int e = tid & 31, part = tid >> 5; int st = 0, sb = 0;
      for (int w = part; w < G; w += 16) { const int c = CNTM[w * 32 + e]; st += c; if (w < bx) sb += c; }
      ptot[part * 32 + e] = st; pbel[part * 32 + e] = sb; }
    __syncthreads();
    if (tid < 32) { int st = 0, sb = 0;
#pragma unroll
        for (int q = 0; q < 16; ++q) { st += ptot[q * 32 + tid]; sb += pbel[q * 32 + tid]; }
        tot[tid] = st; bel[tid] = sb; }
    __syncthreads();
    if (tid == 0) { int acc = 0;
        for (int e = 0; e < NEXP; ++e) { pstart[e] = acc; acc += (tot[e] + 255) & ~255; }
        nb[0] = acc >> 8; }
    __syncthreads();
    if (bx == 0) { const int nblk = nb[0];
        for (int bb = tid; bb < nblk; bb += 512) { int e = 0;
#pragma unroll
            for (int q = 1; q < NEXP; ++q) if (pstart[q] <= bb * 256) e = q;
            F.BLKE()[bb] = e; }
        if (tid == 0) F.BLKE()[NBLK_MAX] = nblk; }
    for (int kk = tid >> 5; bx + kk * G < TV / 16; kk += 16) {
        const int g = bx + kk * G;
        if (l == 1 && row_isctx(g * 16)) continue;
        const int i = g * 32 + (tid & 31);
        const int e = F.ASGE()[i], slot = pstart[e] + bel[e] + F.ASGP()[i];
        F.BUFT()[slot] = i >> 1; F.BUFW()[slot] = F.ASGW()[i]; F.SLOT()[i] = slot;
    }
}

constexpr int vperm(int c) { return 16 * (2 * ((c >> 5) & 3) + ((c >> 2) & 1)) + 4 * ((c >> 3) & 3) + (c & 3); }
DI void mixer_unit(const Frame& F, int l, int cidx, int glo, int ghi) {
    const int tid = opaque_tid(F.wv), wid = tid >> 6, lane = tid & 63, fr = lane & 15, fq = lane >> 4;
    const int row0 = cidx * 128, b = row0 >= SEQV, j0 = row0 - b * SEQV; const bool isctx = j0 < CTX;
    const int slo = b * SEQV + (isctx ? 0 : CTX), nseq = isctx ? CTX : SEQ;
    bf16_t* Vt = (bf16_t*)F.lds;
    constexpr int VP = 136;
    {
        const int tk = tid >> 2, qd = tid & 3;
        const bf16_t* vp = F.PROJ16() + (size_t)(row0 + tk) * 1536 + (GV_OFF - POOL_OFF) + qd * 128;
        const float* ng = F.gmlp_norm_g() + (size_t)l * 512 + qd * 128;
        u32x4 raw[16]; unsigned gp[64];
#pragma unroll
        for (int i = 0; i < 16; ++i) raw[i] = *(const u32x4*)(vp + 8 * i);
        float s = 0.f, s2 = 0.f;
#pragma unroll
        for (int i = 0; i < 16; ++i) { const unsigned ww[4] = {raw[i].x, raw[i].y, raw[i].z, raw[i].w};
#pragma unroll
            for (int e = 0; e < 4; ++e) { const float g0 = gelu_tanh(bflo(ww[e])), g1 = gelu_tanh(bfhi(ww[e])); s += g0 + g1; s2 += g0 * g0 + g1 * g1; gp[4 * i + e] = pk2(g0, g1); } }
        s += __shfl_xor(s, 1); s += __shfl_xor(s, 2); s2 += __shfl_xor(s2, 1); s2 += __shfl_xor(s2, 2);
        const float mean = s * (1.0f / 512.0f), var = s2 * (1.0f / 512.0f) - mean * mean, rstd = rsqrtf(var + EPS);
        bf16_t* Vq = Vt + (size_t)(qd * 128) * VP + tk;
        if (qd >= glo && qd < ghi)
#pragma unroll
        for (int i = 0; i < 16; ++i) {
            const f32x4 ga = *(const f32x4*)(ng + 8 * i), gb = *(const f32x4*)(ng + 8 * i + 4); const float gg[8] = {ga[0], ga[1], ga[2], ga[3], gb[0], gb[1], gb[2], gb[3]};
#pragma unroll
            for (int e = 0; e < 4; ++e) { const unsigned w = gp[4 * i + e]; const float y0 = (bflo(w) - mean) * rstd * gg[2 * e], y1 = (bfhi(w) - mean) * rstd * gg[2 * e + 1];
                const unsigned p = pk2(y0, y1); const int c = 8 * i + 2 * e;
                Vq[(size_t)vperm(c) * VP] = (bf16_t)p; Vq[(size_t)vperm(c + 1) * VP] = (bf16_t)(p >> 16); } }
    }
    __syncthreads();
    const int T0 = row0 + 16 * wid;
    bf16x8 A[4][3];
    {
        const int i = 16 * wid + fr;
        const bf16_t* wsp = F.WSB() + ((size_t)(l * 4) * 128 + i) * 128 + 8 * fq;
        const bf16_t* up = F.PROJ16() + (size_t)(row0 + i) * 1536 + (GU_OFF - POOL_OFF) + 8 * fq;
        const float* bsp = F.gmlp_bs() + (size_t)(l * 4) * 128 + i;
        bf16x8 Aw[4]; u32x4 uw[4]; float bsv = bsp[128 * glo];
#pragma unroll
        for (int ks = 0; ks < 4; ++ks) Aw[ks] = *(const bf16x8*)(wsp + (size_t)glo * 128 * 128 + 32 * ks);
#pragma unroll
        for (int p = 0; p < 4; ++p) uw[p] = *(const u32x4*)(up + 128 * glo + 32 * p);
        for (int g = glo; g < ghi; ++g) {
            f32x4 acc[8];
#pragma unroll
            for (int nb = 0; nb < 8; ++nb) acc[nb] = (f32x4){0.f, 0.f, 0.f, 0.f};
            bf16x8 Awn[4]; u32x4 uwn[4]; float bsn = 0.f;
            if (g + 1 < ghi) {
#pragma unroll
                for (int ks = 0; ks < 4; ++ks) Awn[ks] = *(const bf16x8*)(wsp + (size_t)(g + 1) * 128 * 128 + 32 * ks);
#pragma unroll
                for (int p = 0; p < 4; ++p) uwn[p] = *(const u32x4*)(up + 128 * (g + 1) + 32 * p);
                bsn = bsp[128 * (g + 1)];
            } else {
#pragma unroll
                for (int bz = 0; bz < 3; ++bz) { int row = T0 - 16 + 16 * bz + fr; row = row < 0 ? 0 : (row > TV - 1 ? TV - 1 : row); const bf16_t* pa = F.PROJ16() + (size_t)row * 1536 + 128 * glo + 8 * fq;
#pragma unroll
                    for (int ks = 0; ks < 4; ++ks) A[ks][bz] = *(const bf16x8*)(pa + 32 * ks); }
#pragma unroll
                for (int ks = 0; ks < 4; ++ks) Awn[ks] = Aw[ks];
#pragma unroll
                for (int p = 0; p < 4; ++p) uwn[p] = uw[p];
            }
#pragma unroll
            for (int ks = 0; ks < 4; ++ks) {
#pragma unroll
                for (int nb = 0; nb < 8; ++nb) { const bf16x8 Bv = *(const bf16x8*)(Vt + (size_t)(128 * g + 16 * nb + fr) * VP + 32 * ks + 8 * fq);
                    acc[nb] = __builtin_amdgcn_mfma_f32_16x16x32_bf16(Bv, Aw[ks], acc[nb], 0, 0, 0); } }
            bf16_t* op = F.ACT() + (size_t)(row0 + i) * D + 1536 + 128 * g + 8 * fq;
#pragma unroll
            for (int p = 0; p < 4; ++p) { const unsigned ww[4] = {uw[p].x, uw[p].y, uw[p].z, uw[p].w}; unsigned o[4];
#pragma unroll
                for (int e = 0; e < 4; ++e) { const f32x4 av = acc[2 * p + (e >> 1)]; const int k = 2 * (e & 1);
                    o[e] = pk2(gelu_tanh(bflo(ww[e])) * (av[k] + bsv), gelu_tanh(bfhi(ww[e])) * (av[k + 1] + bsv)); }
                u32x4 w; w.x = o[0]; w.y = o[1]; w.z = o[2]; w.w = o[3]; *(u32x4*)(op + 32 * p) = w; }
#pragma unroll
            for (int ks = 0; ks < 4; ++ks) Aw[ks] = Awn[ks];
#pragma unroll
            for (int p = 0; p < 4; ++p) uw[p] = uwn[p];
            bsv = bsn;
        }
    }
    __syncthreads();
    {
        const bf16_t* src = F.PWT() + (size_t)(l * 4) * 128 * 128;
        u32x4 tmp[16];
#pragma unroll
        for (int i = 0; i < 16; ++i) { const int c = tid + 512 * i; if ((i >> 2) >= glo && (i >> 2) < ghi) tmp[i] = *(const u32x4*)(src + (size_t)(c >> 4) * 128 + (c & 15) * 8); else tmp[i] = (u32x4){0u, 0u, 0u, 0u}; }
#pragma unroll
        for (int i = 0; i < 16; ++i) { const int c = tid + 512 * i, row = c >> 4; if ((i >> 2) >= glo && (i >> 2) < ghi) *(u32x4*)(Vt + (size_t)((row & ~127) + vperm(row & 127)) * VP + (c & 15) * 8) = tmp[i]; }
    }
    __syncthreads();
    for (int g = glo; g < ghi; ++g) {
        const int win = 2 << g, back = win >> 1, fwd = win - 1 - back;
        bf16x8 An[4][3];
        if (g + 1 < ghi) {
#pragma unroll
            for (int bz = 0; bz < 3; ++bz) { int row = T0 - 16 + 16 * bz + fr; row = row < 0 ? 0 : (row > TV - 1 ? TV - 1 : row); const bf16_t* pa = F.PROJ16() + (size_t)row * 1536 + 128 * (g + 1) + 8 * fq;
#pragma unroll
                for (int ks = 0; ks < 4; ++ks) An[ks][bz] = *(const bf16x8*)(pa + 32 * ks); }
        } else {
#pragma unroll
            for (int ks = 0; ks < 4; ++ks)
#pragma unroll
                for (int bz = 0; bz < 3; ++bz) An[ks][bz] = A[ks][bz];
        }
        const int ti = T0 + fr, tloc = ti - slo; int lo = tloc - back; lo = lo < 0 ? 0 : lo; int hi = tloc + fwd; hi = hi > nseq - 1 ? nseq - 1 : hi;
        const float rc = 1.0f / (float)(hi - lo + 1);
        float cf[2][8];
#pragma unroll
        for (int s = 0; s < 2; ++s)
#pragma unroll
            for (int e = 0; e < 8; ++e) { const int bz = 2 * s + (e >> 2); const int tp = T0 - 16 + 16 * bz + 4 * fq + (e & 3); const int tl = tp - slo;
                float cv = (tl >= lo && tl <= hi) ? rc : 0.f; if (tp == ti) cv -= 1.0f; if (bz == 3) cv = 0.f; cf[s][e] = cv; }
        u32x4 a2w[2];
#pragma unroll
        for (int s = 0; s < 2; ++s) { a2w[s].x = pk2(cf[s][0], cf[s][1]); a2w[s].y = pk2(cf[s][2], cf[s][3]); a2w[s].z = pk2(cf[s][4], cf[s][5]); a2w[s].w = pk2(cf[s][6], cf[s][7]); }
        const bf16x8 A20 = __builtin_bit_cast(bf16x8, a2w[0]), A21 = __builtin_bit_cast(bf16x8, a2w[1]);
        const float* psc = F.pool_scale() + (size_t)l * 512 + 128 * g + 8 * fq;
        bf16_t* op = F.ACT() + (size_t)ti * D + 1024 + 128 * g + 8 * fq;
#pragma unroll
        for (int h = 0; h < 2; ++h) {
            f32x4 z[3][4];
#pragma unroll
            for (int bz = 0; bz < 3; ++bz)
#pragma unroll
                for (int q = 0; q < 4; ++q) z[bz][q] = (f32x4){0.f, 0.f, 0.f, 0.f};
            f32x4 scv[2][2];
#pragma unroll
            for (int pp = 0; pp < 2; ++pp) { scv[pp][0] = *(const f32x4*)(psc + 32 * (2 * h + pp)); scv[pp][1] = *(const f32x4*)(psc + 32 * (2 * h + pp) + 4); }
#pragma unroll
            for (int ks = 0; ks < 4; ++ks) {
#pragma unroll
                for (int q = 0; q < 4; ++q) { const bf16x8 B = *(const bf16x8*)(Vt + (size_t)(128 * g + 16 * (4 * h + q) + fr) * VP + 32 * ks + 8 * fq);
#pragma unroll
                    for (int bz = 0; bz < 3; ++bz) z[bz][q] = __builtin_amdgcn_mfma_f32_16x16x32_bf16(A[ks][bz], B, z[bz][q], 0, 0, 0); } }
#pragma unroll
            for (int pp = 0; pp < 2; ++pp) { f32x4 y[2];
#pragma unroll
                for (int o = 0; o < 2; ++o) { const int q = 2 * pp + o;
                    u32x4 b0, b1; b0.x = pk2(z[0][q][0], z[0][q][1]); b0.y = pk2(z[0][q][2], z[0][q][3]); b0.z = pk2(z[1][q][0], z[1][q][1]); b0.w = pk2(z[1][q][2], z[1][q][3]);
                    b1.x = pk2(z[2][q][0], z[2][q][1]); b1.y = pk2(z[2][q][2], z[2][q][3]); b1.z = 0u; b1.w = 0u;
                    y[o] = (f32x4){0.f, 0.f, 0.f, 0.f};
                    y[o] = __builtin_amdgcn_mfma_f32_16x16x32_bf16(__builtin_bit_cast(bf16x8, b0), A20, y[o], 0, 0, 0);
                    y[o] = __builtin_amdgcn_mfma_f32_16x16x32_bf16(__builtin_bit_cast(bf16x8, b1), A21, y[o], 0, 0, 0); }
                const f32x4 y0 = y[0] * scv[pp][0], y1 = y[1] * scv[pp][1];
                u32x4 w; w.x = pk2(y0[0], y0[1]); w.y = pk2(y0[2], y0[3]); w.z = pk2(y1[0], y1[1]); w.w = pk2(y1[2], y1[3]); *(u32x4*)(op + 32 * (2 * h + pp)) = w; }
        }
#pragma unroll
        for (int ks = 0; ks < 4; ++ks)
#pragma unroll
            for (int bz = 0; bz < 3; ++bz) A[ks][bz] = An[ks][bz];
    }
    __syncthreads();
}

DI void phase_qkprep(const Frame& F, int l, int wi, int nw) {
    if (wi < 0) return;
    constexpr int NRQ = 4;
    const int tid = opaque_tid(F.wv), wave = tid >> 6, lane = tid & 63, L7 = lane & 7;
    const int seg = L7 >> 2, isb = (L7 >> 1) & 1, ib = (L7 & 1) * 8;
    const f32x4 gq0 = *(const f32x4*)(F.q_norm_g() + l * 64 + L7 * 8) * QSCALE, gq1 = *(const f32x4*)(F.q_norm_g() + l * 64 + L7 * 8 + 4) * QSCALE;
    const f32x4 gk0 = *(const f32x4*)(F.k_norm_g() + l * 64 + L7 * 8), gk1 = *(const f32x4*)(F.k_norm_g() + l * 64 + L7 * 8 + 4);
    for (int r0 = wi * 8 + wave; r0 < TV; r0 += nw * 8 * NRQ) {
        u32x2 wq[NRQ][4]; f32x4 rc0[NRQ], rc1[NRQ], rs0[NRQ], rs1[NRQ];
#pragma unroll
        for (int q = 0; q < NRQ; ++q) { int r = r0 + q * nw * 8; r = r < TV ? r : TV - 1;
            const int b = r >= SEQV, j = r - b * SEQV; const int tl = j < CTX ? 0 : j - CTX, pos = seg ? (tl & 63) : (tl >> 6);
#pragma unroll
            for (int p = 0; p < 4; ++p) { const int grp = p * 8 + (lane >> 3);
                wq[q][p] = *(const u32x2*)(F.PROJ8() + (size_t)r * 3072 + (grp < 16 ? Q_OFF : K_OFF) + (grp & 15) * 64 + L7 * 8); }
            rc0[q] = *(const f32x4*)(F.ROPE() + pos * 16 + ib); rc1[q] = *(const f32x4*)(F.ROPE() + pos * 16 + ib + 4);
            rs0[q] = *(const f32x4*)(F.ROPE() + 4096 + pos * 16 + ib); rs1[q] = *(const f32x4*)(F.ROPE() + 4096 + pos * 16 + ib + 4); }
#pragma unroll
        for (int q = 0; q < NRQ; ++q) { const int r = r0 + q * nw * 8;
            if (r < TV) {
                const int b = r >= SEQV, j = r - b * SEQV; const bool isctx = j < CTX;
                float cs[8], sn[8];
#pragma unroll
                for (int e = 0; e < 4; ++e) { cs[e] = rc0[q][e]; cs[4 + e] = rc1[q][e]; sn[e] = rs0[q][e]; sn[4 + e] = rs1[q][e]; }
#pragma unroll
                for (int p = 0; p < 4; ++p) {
                    const int grp = p * 8 + (lane >> 3); const bool isq = grp < 16;
                    const u32x2 w = wq[q][p];
                    const int krow = j & 63;
                    char* kdst = F.KIMG() + ((size_t)((b * 16 + (grp & 15)) * NTILE + (j >> 6))) * 4096 + krow * 64 + ((((L7 >> 1) ^ ((krow >> 2) & 3)) << 4) | ((L7 & 1) << 3));
                    unsigned char* qdst = F.Q8() + ((size_t)r * 16 + (grp & 15)) * 64 + L7 * 8;
                    typedef float f2 __attribute__((ext_vector_type(2)));
                    const f2 x01 = __builtin_amdgcn_cvt_pk_f32_fp8(w.x, false), x23 = __builtin_amdgcn_cvt_pk_f32_fp8(w.x, true), x45 = __builtin_amdgcn_cvt_pk_f32_fp8(w.y, false), x67 = __builtin_amdgcn_cvt_pk_f32_fp8(w.y, true);
                    float x[8] = {x01[0], x01[1], x23[0], x23[1], x45[0], x45[1], x67[0], x67[1]};
                    float ss = 0.f;
#pragma unroll
                    for (int e = 0; e < 8; ++e) ss += x[e] * x[e];
                    ss += __shfl_xor(ss, 1); ss += __shfl_xor(ss, 2); ss += __shfl_xor(ss, 4);
                    const float rs = rsqrtf(ss * (1.0f / 64.0f) + EPS);
                    const f32x4 g0 = (isq ? gq0 : gk0) * rs, g1 = (isq ? gq1 : gk1) * rs;
                    float y[8];
#pragma unroll
                    for (int e = 0; e < 4; ++e) { y[e] = x[e] * g0[e]; y[4 + e] = x[4 + e] * g1[e]; }
                    if (!isctx) {
#pragma unroll
                        for (int e = 0; e < 8; ++e) { const float pr = __shfl_xor(y[e], 2); y[e] = isb ? (y[e] * cs[e] + pr * sn[e]) : (y[e] * cs[e] - pr * sn[e]); }
                    }
                    int w0 = __builtin_amdgcn_cvt_pk_fp8_f32(y[0], y[1], 0, false); w0 = __builtin_amdgcn_cvt_pk_fp8_f32(y[2], y[3], w0, true);
                    int w1 = __builtin_amdgcn_cvt_pk_fp8_f32(y[4], y[5], 0, false); w1 = __builtin_amdgcn_cvt_pk_fp8_f32(y[6], y[7], w1, true);
                    u32x2 o; o.x = (unsigned)w0; o.y = (unsigned)w1;
                    if (isq) *(u32x2*)qdst = o; else *(u32x2*)kdst = o;
                }
            }
        }
    }
}

DI void phase_vprep(const Frame& F, int wi, int nw) {
    if (wi < 0) return;
    const int tid = opaque_tid(F.wv), half = tid >> 8, c0 = 4 * (tid & 255), h = c0 >> 7, n0 = c0 & 127;
    for (int u = wi * 2 + half; u < NB * NTILE; u += nw * 2) {
        const int b = u / NTILE, tile = u % NTILE;
        const unsigned char* src = F.PROJ8() + (size_t)(b * SEQV + tile * 64) * 3072 + V_OFF + c0;
        char* dst = F.VIMG() + ((size_t)((b * 8 + h) * NTILE + tile)) * 8192;
        unsigned W[64];
#pragma unroll
        for (int pp = 0; pp < 64; ++pp) { const int r = pp & 15, key = ((pp >> 4) & 1) * 32 + (r & 3) + 8 * (r >> 2) + 4 * (pp >> 5); W[pp] = *(const unsigned*)(src + (size_t)key * 3072); }
#pragma unroll
        for (int ch = 0; ch < 4; ++ch) {
            unsigned o[4][4];
#pragma unroll
            for (int q = 0; q < 4; ++q) { const unsigned w0 = W[16 * ch + 4 * q], w1 = W[16 * ch + 4 * q + 1], w2 = W[16 * ch + 4 * q + 2], w3 = W[16 * ch + 4 * q + 3];
                const unsigned x0 = __builtin_amdgcn_perm(w1, w0, 0x05010400u), x1 = __builtin_amdgcn_perm(w1, w0, 0x07030602u);
                const unsigned y0 = __builtin_amdgcn_perm(w3, w2, 0x05010400u), y1 = __builtin_amdgcn_perm(w3, w2, 0x07030602u);
                o[0][q] = __builtin_amdgcn_perm(y0, x0, 0x05040100u); o[1][q] = __builtin_amdgcn_perm(y0, x0, 0x07060302u);
                o[2][q] = __builtin_amdgcn_perm(y1, x1, 0x05040100u); o[3][q] = __builtin_amdgcn_perm(y1, x1, 0x07060302u); }
#pragma unroll
            for (int c = 0; c < 4; ++c) { const int n = n0 + c; const u32x4 v = {o[c][0], o[c][1], o[c][2], o[c][3]};
                *(u32x4*)(dst + n * 64 + ((ch ^ ((n >> 2) & 3)) << 4)) = v; }
        }
    }
}

#ifndef PHMASK
#define PHMASK 0xFFFF
#endif
#define PHON(k) (((PHMASK) >> (k)) & 1)
#ifndef REP_PRO
#define REP_PRO 1
#endif
#ifndef REP_WIN
#define REP_WIN 1
#endif
#ifndef REP_MIX
#define REP_MIX 1
#endif
#ifndef REP_MOE
#define REP_MOE 1
#endif
#ifndef REP_ROW
#define REP_ROW 1
#endif
#ifndef REP_WOUT
#define REP_WOUT 1
#endif
constexpr int NPH = 26;

__global__ void __launch_bounds__(512, 2) fwd(Args args) {
    extern __shared__ __attribute__((aligned(16))) unsigned char lds[];
    Frame F0{args, 0, (char*)lds, (int)gridDim.x, 0, __builtin_amdgcn_readfirstlane((int)(threadIdx.x >> 6))};
    { const int bx = blockIdx.x; F0.vcu = (F0.G % 8 == 0) ? (bx % 8) * (F0.G / 8) + bx / 8 : bx; }
    LAS unsigned char* ldsl = (LAS unsigned char*)lds;
    if (threadIdx.x < 16) ((LAS unsigned*)(ldsl + MISC_OFF))[threadIdx.x] = 0u;
    __syncthreads();
    const int lo = args.ph_lo, hi = args.ph_hi;
    XcdBarrier bar; bar.bar = F0.ctl(); bar.x = 0; bar.wv = F0.wv; bar.st = (volatile LAS unsigned*)(ldsl + MISC_OFF);
    if (hi - lo > 1) bar = xcd_barrier_post(F0.ctl(), (volatile LAS unsigned*)(ldsl + MISC_OFF), F0.wv);
#define IN(k) (lo <= (k) && (k) < hi)
#ifndef REP_BAR
#define REP_BAR 1
#endif
#define SEAM(k) do { if (IN((k) + 1)) { for (int _rb = 0; _rb < REP_BAR; ++_rb) xcd_barrier(bar); } } while (0)

    if (PHON(0) && IN(0)) { const Frame F = fresh(F0); for (int rep = 0; rep < REP_PRO; ++rep) phase_prologue(F); SEAM(0); }

#pragma unroll
    for (int l = 0; l < DEPTH; ++l) {
        const int pb = 1 + 12 * l;
        if (PHON(1) && IN(pb + 0)) { const Frame F = fresh(F0); if (l == 0) phase_norm1<0>(F); else phase_norm1<1>(F);
            SEAM(pb + 0); }
        if (PHON(2) && IN(pb + 1)) { const Frame F = fresh(F0);
            pg8::Gemm g{F.ACT(), (const bf16_t*)((const unsigned char*)F.WIN() + (size_t)l * INC * D), D, nullptr}; pg8::StaticOrder S; S.init(TV / 256, INC / 256, F.G, (int)blockIdx.x, 0);
            pg8::EpiProj E{F.PROJ8(), F.PROJ16(), 1.0f / 32.0f};
            for (int rep = 0; rep < REP_WIN; ++rep) pg8::gemm_phase<pg8::EpiProj, pg8::StaticOrder, false, true>(ldsl, g, S, E, F.wv);
            SEAM(pb + 1);
        }
        if (PHON(3) && IN(pb + 2)) { const Frame F = fresh(F0);
            for (int rep = 0; rep < REP_MIX; ++rep) {
                for (int k = F.vcu; k < 2 * (SEQ / 128); k += F.G) mixer_unit(F, l, k < SEQ / 128 ? 2 + k : 4 + k, 0, 4);
                if (l == 0) for (int q = F.vcu; q < 16; q += F.G) { const int cc = q >> 2; mixer_unit(F, l, (cc >> 1) * (SEQV / 128) + (cc & 1), q & 3, (q & 3) + 1); }
            }
            const int nx = (l == 0 && F.G > 32) ? 16 : 0, wi = F.vcu - nx, nw = F.G - nx;
            phase_qkprep(F, l, wi, nw);
            phase_vprep(F, wi, nw);
            SEAM(pb + 2);
        }
        if (PHON(4) && IN(pb + 3)) { const Frame F = fresh(F0);
            const int nu = l == 0 ? 1024 + 16 : 1024;
            const float lam = F.LAM()[l], oml = 1.0f - (l == 0 ? 0.2f : 0.8f - 0.6f * 0.7408182206817179f);
            float* sgl = (float*)(F.lds + att::SHM_ATTN);
            { const int t_ = opaque_tid(F.wv); __syncthreads(); if (t_ < 128) sgl[t_] = F.subln_g()[(size_t)l * 128 + t_] * oml; __syncthreads(); }
            u32x4* park = F.PARK() + ((size_t)blockIdx.x * 512 + opaque_tid(F.wv)) * 8;
#ifndef REP_ATT
#define REP_ATT 1
#endif
            for (int rep = 0; rep < REP_ATT; ++rep)
            for (int u = F.vcu; u < nu; u += F.G) {
                int b, h, qrow0, nt;
                if (u < 1024) { const int qb = u & 63, bh = u >> 6; b = bh >> 3; h = bh & 7; qrow0 = b * SEQV + CTX + qb * 256; nt = NTILE; }
                else { const int bh = u - 1024; b = bh >> 3; h = bh & 7; qrow0 = b * SEQV; nt = CTX / 64; }
                const unsigned char* Qb = F.Q8() + ((size_t)qrow0 * 16 + h * 2) * 64;
                const char* Kimg = F.KIMG() + (size_t)((b * 16 + h * 2) * NTILE) * 4096;
                const char* Vimg = F.VIMG() + (size_t)((b * 8 + h) * NTILE) * 8192;
                bf16_t* Yb = F.ACT() + (size_t)qrow0 * D + h * 128;
                att::attn_unit(Qb, Kimg, Vimg, Yb, park, lam, sgl, nt, F.lds, ldsl, F.wv);
            }
            if (IN(pb + 5)) xcd_barrier(bar);
        }
        if (PHON(6) && IN(pb + 5)) { const Frame F = fresh(F0);
            pg8::Gemm g{F.ACT(), F.WOUT() + (size_t)l * D * D, D, nullptr}; pg8::StaticOrder S; S.init(l == 0 ? TV / 256 : NB * SEQ / 256, D / 256, F.G, (int)blockIdx.x, l == 1);
            pg8::EpiWout E{F.XB(), F.MOD() + (size_t)l * 18 * D};
            for (int rep = 0; rep < (l == 0 ? REP_WOUT : 1); ++rep) pg8::gemm_phase<pg8::EpiWout, pg8::StaticOrder, false>(ldsl, g, S, E, F.wv);
            SEAM(pb + 5);
        }
        if (PHON(7) && IN(pb + 6)) { const Frame F = fresh(F0); phase_norm2r(F, l);
            if (IN(pb + 9)) xcd_barrier(bar); }
        if (PHON(10) && IN(pb + 9)) { const Frame F = fresh(F0); phase_slots(F, l); SEAM(pb + 9); }
        if (PHON(11) && IN(pb + 10)) { const Frame F = fresh(F0);
            const int nblk = __builtin_amdgcn_readfirstlane(F.BLKE()[NBLK_MAX]);
            pg8::Gemm g{(const bf16_t*)F.ACT8(), (const bf16_t*)((const unsigned char*)F.GU() + (size_t)l * NEXP * 1024 * D), D, F.BUFT()}; LAS int* lblk = (LAS int*)(ldsl + 135168);
            { const int t_ = opaque_tid(F.wv); __syncthreads(); for (int i = t_; i < nblk; i += 512) lblk[i] = F.BLKE()[i]; __syncthreads(); }
            pg8::MoeOrder S{lblk, nblk * 4, F.G, F.vcu, 4};
            pg8::EpiGU E{(unsigned char*)F.HID(), 1.0f / 32.0f};
            for (int rep = 0; rep < REP_MOE; ++rep) pg8::gemm_phase<pg8::EpiGU, pg8::MoeOrder, true, true>(ldsl, g, S, E, F.wv);
            SEAM(pb + 10);
        }
        if (PHON(12) && IN(pb + 11)) { const Frame F = fresh(F0);
            const int nblk = __builtin_amdgcn_readfirstlane(F.BLKE()[NBLK_MAX]);
            pg8::Gemm g{F.HID(), (const bf16_t*)((const unsigned char*)F.WD() + (size_t)l * NEXP * D * FF), FF, nullptr}; LAS int* lblk = (LAS int*)(ldsl + 135168);
            { const int t_ = opaque_tid(F.wv); __syncthreads(); for (int i = t_; i < nblk; i += 512) lblk[i] = F.BLKE()[i]; __syncthreads(); }
            pg8::MoeOrder S{lblk, nblk * 8, F.G, F.vcu, 8};
            pg8::EpiDown E{(unsigned char*)F.YBUF(), F.BUFW(), 1.0f / 16.0f};
            for (int rep = 0; rep < REP_MOE; ++rep) pg8::gemm_phase<pg8::EpiDown, pg8::MoeOrder, false, true>(ldsl, g, S, E, F.wv);
            SEAM(pb + 11);
        }
    }
    if (PHON(13) && IN(25)) { const Frame F = fresh(F0); phase_final(F); }
#undef IN
#undef SEAM
}

extern "C" void kernel_launch(void* const* d_in, const int* in_sizes, int n_in, void* d_out, int out_size, void* d_ws, size_t ws_size, hipStream_t stream) {
    static int grid = 0;
    if (grid == 0) {
        if (n_in != 29 || out_size != NB * SEQ * D || ws_size < WS_END) { fprintf(stderr, "kernel_launch: built for 29 inputs, out %d floats, >= %zu bytes of workspace; got n_in %d, out %d, ws %zu\n", NB * SEQ * D, (size_t)WS_END, n_in, out_size, ws_size); grid = -1; return; }
        int dev = 0, cus = 0, per_cu = 0;
        if (hipGetDevice(&dev) != hipSuccess || hipDeviceGetAttribute(&cus, hipDeviceAttributeMultiprocessorCount, dev) != hipSuccess) { fprintf(stderr, "kernel_launch: device query failed\n"); grid = -1; return; }
        if (hipFuncSetAttribute((const void*)fwd, hipFuncAttributeMaxDynamicSharedMemorySize, LDS_BYTES) != hipSuccess) { fprintf(stderr, "kernel_launch: hipFuncSetAttribute failed\n"); grid = -1; return; }
        if (hipOccupancyMaxActiveBlocksPerMultiprocessor(&per_cu, (const void*)fwd, 512, LDS_BYTES) != hipSuccess || per_cu < 1)
            fprintf(stderr, "kernel_launch: note: occupancy query reports %d workgroups per CU\n", per_cu);
        (void)hipGetLastError();
        grid = cus;
    }
    if (grid < 0) return;
    if (hipMemsetAsync((char*)d_ws + WS_CTL, 0, CTL_BYTES, stream) != hipSuccess) { fprintf(stderr, "kernel_launch: memset failed\n"); return; }
    Args a{};
    for (int i = 0; i < 29; ++i) a.in[i] = (const float*)d_in[i];
    a.out = (float*)d_out; a.ws = (unsigned char*)d_ws;
#if MK_MULTI
    for (int p = 0; p < NPH; ++p) { a.ph_lo = p; a.ph_hi = p + 1; hipLaunchKernelGGL(fwd, dim3(grid), dim3(512), LDS_BYTES, stream, a); }
#else
    a.ph_lo = 0; a.ph_hi = NPH;
    hipLaunchKernelGGL(fwd, dim3(grid), dim3(512), LDS_BYTES, stream, a);
#endif
    const hipError_t le = hipPeekAtLastError();
    if (le != hipSuccess) fprintf(stderr, "kernel_launch: launch failed: %s\n", hipGetErrorName(le));
}
```
